# Optimizing an MI355X kernel written in HIP

```python
import jax, jax.numpy as jnp
from jax import lax
import numpy as np

D_MODEL = 1024
BATCH = 4
SEQ = 4096
DEPTH = 1
DEC_BATCH = 128
DEC_SEQ = 4
PAST_LEN = 8192
PAGE_SIZE = 128

MIX_WIDTH = D_MODEL
ATT_WIDTH = MIX_WIDTH // 2
HG_WIDTH = MIX_WIDTH - ATT_WIDTH
ATT_HEAD_DIM = 64
ATT_HEADS = ATT_WIDTH // ATT_HEAD_DIM
DILATIONS = ((128, 1), (512, 4), (2048, 16))
ATT_WINDOW_MAX = 2048
ATT_BLOCK = 128
ROPE_THETA = 10000.0
HG_EXPAND = 128
HG_HEADS = HG_WIDTH // HG_EXPAND
HG_DK = HG_EXPAND
HG_DV = HG_WIDTH // HG_HEADS
HG_CHUNK = 32
D_FF = 2816
IN_COLS = 3 * ATT_WIDTH + 4 * HG_WIDTH
IN_SPLITS = [ATT_WIDTH, 2 * ATT_WIDTH, 3 * ATT_WIDTH,
             3 * ATT_WIDTH + HG_WIDTH, 3 * ATT_WIDTH + 2 * HG_WIDTH, 3 * ATT_WIDTH + 3 * HG_WIDTH]
DN_ALPHA = (2.0 * DEPTH) ** 0.25
DN_BETA = (8.0 * DEPTH) ** -0.25
LN_EPS = 1e-5
NEG_INF = -1e30

kernel_name = "hymba_longnet_hgrn2_macaron_deepnorm_step"


def layer_norm(x, g, b):
    xf = x.astype(jnp.float32)
    mu = jnp.mean(xf, axis=-1, keepdims=True)
    var = jnp.mean(jnp.square(xf - mu), axis=-1, keepdims=True)
    return ((xf - mu) * lax.rsqrt(var + LN_EPS)).astype(x.dtype) * g + b


def head_rms(o):
    of = o.astype(jnp.float32)
    return (of * lax.rsqrt(jnp.mean(of * of, axis=-1, keepdims=True) + LN_EPS)).astype(o.dtype)


def swiglu(x, w_gate, w_up, w_down):
    return (jax.nn.silu(x @ w_gate) * (x @ w_up)) @ w_down


def rope(x, pos):
    half = x.shape[-1] // 2
    inv = ROPE_THETA ** (-jnp.arange(half, dtype=jnp.float32) / half)
    ang = pos.astype(jnp.float32)[:, None] * inv[None, :]
    cos = jnp.cos(ang)[:, None, :].astype(x.dtype)
    sin = jnp.sin(ang)[:, None, :].astype(x.dtype)
    x1, x2 = x[..., :half], x[..., half:]
    return jnp.concatenate([x1 * cos - x2 * sin, x2 * cos + x1 * sin], axis=-1)


def project(x, w_in, lb, pos):
    b, t, _ = x.shape
    z = x @ w_in
    qa, ka, va, qh, fh, ih, gh = jnp.split(z, IN_SPLITS, axis=-1)
    qa = rope(qa.reshape(b, t, ATT_HEADS, ATT_HEAD_DIM), pos)
    ka = rope(ka.reshape(b, t, ATT_HEADS, ATT_HEAD_DIM), pos)
    va = va.reshape(b, t, ATT_HEADS, ATT_HEAD_DIM)
    zf = fh.astype(jnp.float32).reshape(b, t, HG_HEADS, HG_DK)
    lbh = lb.reshape(HG_HEADS, HG_DK)
    logf = jnp.log(lbh + (1.0 - lbh) * jax.nn.sigmoid(zf))
    kh = (1.0 - lbh) * jax.nn.sigmoid(-zf)
    qh = jax.nn.silu(qh).reshape(b, t, HG_HEADS, HG_DK)
    ih = ih.reshape(b, t, HG_HEADS, HG_DV)
    return (qa, ka, va), (qh, kh, ih, logf), gh


def dilated_branch_prompt(q, k, v, window, dil):
    b, t, h, e = q.shape
    w_sub = window // dil
    span = dil * ATT_BLOCK
    t_pad = -(-t // span) * span
    n_blk = t_pad // span

    def to_sub(a):
        a = jnp.pad(a, ((0, 0), (0, t_pad - t), (0, 0), (0, 0)))
        a = a.reshape(b, t_pad // dil, dil, h, e).transpose(0, 2, 1, 3, 4)
        return a.reshape(b, dil, n_blk, ATT_BLOCK, h, e)

    qs, ks, vs = to_sub(q), to_sub(k), to_sub(v)
    prev = ((0, 0), (0, 0), (1, 0), (0, 0), (0, 0), (0, 0))
    kb = jnp.concatenate([jnp.pad(ks, prev)[:, :, :-1], ks], axis=3)
    vb = jnp.concatenate([jnp.pad(vs, prev)[:, :, :-1], vs], axis=3)
    qi = jnp.arange(ATT_BLOCK)[:, None]
    kc = jnp.arange(2 * ATT_BLOCK)[None, :]
    dist = qi + ATT_BLOCK - kc
    rel = (dist >= 0) & (dist <= w_sub)
    has_prev = (jnp.arange(n_blk) > 0)[:, None, None] | (kc >= ATT_BLOCK)[None]
    mask = rel[None] & has_prev
    s = jnp.einsum('bdnqhe,bdnkhe->bdnhqk', qs, kb).astype(jnp.float32) * (e ** -0.5)
    s = jnp.where(mask[None, None, :, None], s, NEG_INF)
    lse = jax.nn.logsumexp(s, axis=-1)
    p = jnp.exp(s - lse[..., None]).astype(v.dtype)
    o = jnp.einsum('bdnhqk,bdnkhe->bdnqhe', p, vb)
    o = o.reshape(b, dil, t_pad // dil, h, e).transpose(0, 2, 1, 3, 4).reshape(b, t_pad, h, e)[:, :t]
    lse = lse.transpose(0, 1, 2, 4, 3).reshape(b, dil, t_pad // dil, h)
    lse = lse.transpose(0, 2, 1, 3).reshape(b, t_pad, h)[:, :t]
    return o, lse


def dilated_branch_sample(q, k_all, v_all, past_rows, window, dil):
    s_len, e = q.shape[1], q.shape[-1]
    n_keys = window // dil + 1
    idx = past_rows + jnp.arange(s_len)[:, None] - dil * jnp.arange(n_keys)[None, :]
    valid = idx >= 0
    idx = jnp.maximum(idx, 0)
    kg = k_all[:, idx]
    vg = v_all[:, idx]
    s = jnp.einsum('bshe,bsjhe->bshj', q, kg).astype(jnp.float32) * (e ** -0.5)
    s = jnp.where(valid[None, :, None, :], s, NEG_INF)
    lse = jax.nn.logsumexp(s, axis=-1)
    p = jnp.exp(s - lse[..., None]).astype(v_all.dtype)
    o = jnp.einsum('bshj,bsjhe->bshe', p, vg)
    return o, lse


def combine_branches(branches):
    lse = jnp.stack([l for _, l in branches], axis=0)
    wts = jax.nn.softmax(lse, axis=0)
    o = sum(wts[i][..., None] * branches[i][0].astype(jnp.float32) for i in range(len(branches)))
    return o.astype(branches[0][0].dtype)


def hgrn2_chunked(q, k, v, logf, s0):
    b, t, h, dk = q.shape
    dv = v.shape[-1]
    t_pad = -(-t // HG_CHUNK) * HG_CHUNK
    n_ch = t_pad // HG_CHUNK

    def chunks(a):
        a = jnp.pad(a.astype(jnp.float32), ((0, 0), (0, t_pad - t), (0, 0), (0, 0)))
        return a.reshape(b, n_ch, HG_CHUNK, h, a.shape[-1])

    qc, kc, vc, gc = chunks(q), chunks(k), chunks(v), chunks(logf)
    cum = jnp.cumsum(gc, axis=2)
    cum_end = cum[:, :, -1:]
    q_dec = qc * jnp.exp(cum)
    k_dec = kc * jnp.exp(-cum)
    k_end = kc * jnp.exp(cum_end - cum)
    causal = jnp.tril(jnp.ones((HG_CHUNK, HG_CHUNK), dtype=bool))
    a = jnp.einsum('bnihk,bnjhk->bnhij', q_dec, k_dec)
    a = jnp.where(causal, a, 0.0)
    o_intra = jnp.einsum('bnhij,bnjhv->bnihv', a, vc)
    u = jnp.einsum('bnjhk,bnjhv->bnhkv', k_end, vc)
    decay = jnp.exp(cum_end[:, :, 0])

    def step(state, inp):
        dec, upd = inp
        return dec[..., None] * state + upd, state

    s_final, s_start = lax.scan(step, s0.astype(jnp.float32),
                                (decay.transpose(1, 0, 2, 3), u.transpose(1, 0, 2, 3, 4)))
    s_start = s_start.transpose(1, 0, 2, 3, 4)
    o_inter = jnp.einsum('bnihk,bnhkv->bnihv', q_dec, s_start)
    o = (o_intra + o_inter).reshape(b, t_pad, h, dv)[:, :t]
    return o.astype(v.dtype), s_final.astype(s0.dtype)


def mix_out(o_att, o_hg, gh, hg_norm_g, w_out):
    b, t = o_att.shape[:2]
    o_hg = head_rms(o_hg).reshape(b, t, HG_WIDTH) * hg_norm_g * jax.nn.silu(gh)
    cat = jnp.concatenate([o_att.reshape(b, t, ATT_WIDTH), o_hg.astype(o_att.dtype)], axis=-1)
    return cat @ w_out


def setup_inputs(seed: int = 0) -> dict:
    key = jax.random.key(seed)
    ks = jax.random.split(key, 24)
    win_buf = min(ATT_WINDOW_MAX, PAST_LEN)

    def nrm(k, shape, scale):
        return jax.random.normal(k, shape, jnp.float32) * scale

    col_scale = jnp.ones((IN_COLS,), jnp.float32)
    col_scale = col_scale.at[2 * ATT_WIDTH:3 * ATT_WIDTH].set(DN_BETA)
    col_scale = col_scale.at[3 * ATT_WIDTH + 2 * HG_WIDTH:3 * ATT_WIDTH + 3 * HG_WIDTH].set(DN_BETA)
    return {
        "x_prompt": nrm(ks[0], (BATCH, SEQ, D_MODEL), 1.0),
        "x_sample": nrm(ks[1], (DEC_BATCH, DEC_SEQ, D_MODEL), 1.0),
        "cache_k": nrm(ks[2], (DEPTH, DEC_BATCH, win_buf, ATT_HEADS, ATT_HEAD_DIM), 1.0),
        "cache_v": nrm(ks[3], (DEPTH, DEC_BATCH, win_buf, ATT_HEADS, ATT_HEAD_DIM), DN_BETA),
        "state_hgrn": nrm(ks[4], (DEPTH, DEC_BATCH, HG_HEADS, HG_DK, HG_DV), 0.5),
        "ffn1_w_gate": nrm(ks[5], (DEPTH, D_MODEL, D_FF), D_MODEL ** -0.5),
        "ffn1_w_up": nrm(ks[6], (DEPTH, D_MODEL, D_FF), D_MODEL ** -0.5),
        "ffn1_w_down": nrm(ks[7], (DEPTH, D_FF, D_MODEL), DN_BETA * D_FF ** -0.5),
        "ln1_g": 1.0 + nrm(ks[8], (DEPTH, D_MODEL), 0.1),
        "ln1_b": nrm(ks[9], (DEPTH, D_MODEL), 0.02),
        "w_in": nrm(ks[10], (DEPTH, D_MODEL, IN_COLS), D_MODEL ** -0.5) * col_scale,
        "hg_lower_bound": nrm(ks[11], (DEPTH + 1, HG_WIDTH), 0.1),
        "hg_norm_g": 1.0 + nrm(ks[12], (DEPTH, HG_WIDTH), 0.1),
        "w_out": nrm(ks[13], (DEPTH, MIX_WIDTH, D_MODEL), DN_BETA * MIX_WIDTH ** -0.5),
        "ln2_g": 1.0 + nrm(ks[14], (DEPTH, D_MODEL), 0.1),
        "ln2_b": nrm(ks[15], (DEPTH, D_MODEL), 0.02),
        "ffn2_w_gate": nrm(ks[16], (DEPTH, D_MODEL, D_FF), D_MODEL ** -0.5),
        "ffn2_w_up": nrm(ks[17], (DEPTH, D_MODEL, D_FF), D_MODEL ** -0.5),
        "ffn2_w_down": nrm(ks[18], (DEPTH, D_FF, D_MODEL), DN_BETA * D_FF ** -0.5),
        "ln3_g": 1.0 + nrm(ks[19], (DEPTH, D_MODEL), 0.1),
        "ln3_b": nrm(ks[20], (DEPTH, D_MODEL), 0.02),
    }


def reference(x_prompt, x_sample, cache_k, cache_v, state_hgrn,
              ffn1_w_gate, ffn1_w_up, ffn1_w_down, ln1_g, ln1_b,
              w_in, hg_lower_bound, hg_norm_g, w_out, ln2_g, ln2_b,
              ffn2_w_gate, ffn2_w_up, ffn2_w_down, ln3_g, ln3_b):
    lower_bounds = jnp.cumsum(jax.nn.softmax(hg_lower_bound.astype(jnp.float32), axis=0), axis=0)
    t_p = x_prompt.shape[1]
    t_s = x_sample.shape[1]
    past_rows = cache_k.shape[2]
    win_p = min(ATT_WINDOW_MAX, t_p)
    pos_p = jnp.arange(t_p, dtype=jnp.int32)
    pos_s = PAST_LEN + jnp.arange(t_s, dtype=jnp.int32)
    xp, xs = x_prompt, x_sample
    kp_l, vp_l, sp_l, ks_l, vs_l, ss_l = [], [], [], [], [], []
    for l in range(DEPTH):
        xp = layer_norm(DN_ALPHA * xp + 0.5 * swiglu(xp, ffn1_w_gate[l], ffn1_w_up[l], ffn1_w_down[l]),
                        ln1_g[l], ln1_b[l])
        xs = layer_norm(DN_ALPHA * xs + 0.5 * swiglu(xs, ffn1_w_gate[l], ffn1_w_up[l], ffn1_w_down[l]),
                        ln1_g[l], ln1_b[l])

        (qa, ka, va), hg, gh = project(xp, w_in[l], lower_bounds[l], pos_p)
        o_att = combine_branches([dilated_branch_prompt(qa, ka, va, w, d) for (w, d) in DILATIONS])
        s0 = jnp.zeros((xp.shape[0], HG_HEADS, HG_DK, HG_DV), state_hgrn.dtype)
        o_hg, s_p = hgrn2_chunked(hg[0], hg[1], hg[2], hg[3], s0)
        mix_p = mix_out(o_att, o_hg, gh, hg_norm_g[l], w_out[l])
        kp_l.append(ka[:, t_p - win_p:])
        vp_l.append(va[:, t_p - win_p:])
        sp_l.append(s_p)

        (qa_s, ka_s, va_s), hg_s, gh_s = project(xs, w_in[l], lower_bounds[l], pos_s)
        k_all = jnp.concatenate([cache_k[l].astype(ka_s.dtype), ka_s], axis=1)
        v_all = jnp.concatenate([cache_v[l].astype(va_s.dtype), va_s], axis=1)
        o_att_s = combine_branches([dilated_branch_sample(qa_s, k_all, v_all, past_rows, w, d)
                                    for (w, d) in DILATIONS])
        o_hg_s, s_s = hgrn2_chunked(hg_s[0], hg_s[1], hg_s[2], hg_s[3], state_hgrn[l])
        mix_s = mix_out(o_att_s, o_hg_s, gh_s, hg_norm_g[l], w_out[l])
        ks_l.append(k_all[:, -past_rows:])
        vs_l.append(v_all[:, -past_rows:])
        ss_l.append(s_s)

        xp = layer_norm(DN_ALPHA * xp + mix_p, ln2_g[l], ln2_b[l])
        xs = layer_norm(DN_ALPHA * xs + mix_s, ln2_g[l], ln2_b[l])

        xp = layer_norm(DN_ALPHA * xp + 0.5 * swiglu(xp, ffn2_w_gate[l], ffn2_w_up[l], ffn2_w_down[l]),
                        ln3_g[l], ln3_b[l])
        xs = layer_norm(DN_ALPHA * xs + 0.5 * swiglu(xs, ffn2_w_gate[l], ffn2_w_up[l], ffn2_w_down[l]),
                        ln3_g[l], ln3_b[l])
    return (xp, xs, jnp.stack(kp_l), jnp.stack(vp_l), jnp.stack(sp_l),
            jnp.stack(ks_l), jnp.stack(vs_l), jnp.stack(ss_l))
```

```cpp
#ifndef DBG
#define DBG 0
#endif
#ifndef PHMASK
#define PHMASK 0xFFFF
#endif
#include <hip/hip_runtime.h>
#include <cstdio>
#include <cstdint>
namespace pg8 {
#define PG8_LAS __attribute__((address_space(3)))
typedef unsigned short bf16_t;
typedef short bf16x8 __attribute__((ext_vector_type(8)));
typedef float f32x4 __attribute__((ext_vector_type(4)));
typedef unsigned u32x4 __attribute__((ext_vector_type(4)));
constexpr int BM = 256, BK = 64, HALF = 128, HTB = HALF * BK * 2  , STAGE_BYTES = 8 * HTB, NXCD = 8, WGM = 8;

__host__ __device__ __forceinline__ int lds_byte(int r, int c) { const int st = (r >> 4) * 2 + (c >> 5), rr = r & 15, cc = c & 31, ob = rr * 64 + cc * 2; return st * 1024 + (ob ^ (((ob >> 9) & 1) << 5)); }
__host__ __device__ __forceinline__ void stage_rc(int b, int& R, int& C) { const int st = b / 1024, sb = b % 1024, swz = sb ^ (((sb >> 9) & 1) << 5); R = (st >> 1) * 16 + swz / 64; C = (st & 1) * 32 + (swz % 64) / 2; }
__host__ __device__ __forceinline__ int perm32(int rho) { const int n = rho >> 4, i = rho & 15; return 8 * (i >> 2) + 4 * n + (i & 3); }

struct Unit { int pm, pn; };
struct Gemm { const bf16_t* A; const bf16_t* Bt; int M, N, K; };

struct StaticOrder {
    int nM, nN, nwg, G, c;
    __host__ __device__ void init(int M, int N, int G_, int c_) { nM = M / BM; nN = N / BM; nwg = nM * nN; G = G_; c = c_; }
    __host__ __device__ bool next(int i, Unit& u) const {
        const long L = (long)i * G + c; if (L >= nwg) return false;
        int wgid = (int)L; { const int q = nwg / NXCD, r = nwg % NXCD, xcd = wgid % NXCD, off = wgid / NXCD; wgid = (xcd < r ? xcd * (q + 1) : r * (q + 1) + (xcd - r) * q) + off; }
        const int nig = WGM * nN, gid = wgid / nig, fm = gid * WGM, gsz = (nM - fm) < WGM ? (nM - fm) : WGM;
        u.pm = fm + ((wgid % nig) % gsz); u.pn = (wgid % nig) / gsz; return true;
    }
    __device__ __forceinline__ void a_ready(const Unit&) const {}
    __device__ __forceinline__ void done(const Unit&) const {}
};

__device__ __forceinline__ unsigned cvt_pk_bf16(float lo, float hi) { unsigned r; asm volatile("v_cvt_pk_bf16_f32 %0, %1, %2" : "=v"(r) : "v"(lo), "v"(hi)); return r; }
typedef float f32x2 __attribute__((ext_vector_type(2)));
typedef unsigned u32x2 __attribute__((ext_vector_type(2)));
__device__ __forceinline__ float fsig(float x) { return __builtin_amdgcn_rcpf(1.0f + __expf(-x)); }
__device__ __forceinline__ float fsilu(float x) { return x * fsig(x); }

struct EpiSwiGLU {
    static constexpr bool PERM = true, AFTER_DRAIN = false;
    bf16_t* H; int ldh;
    __device__ __forceinline__ void operator()(const f32x4 (&acc)[2][2][4][2], const Unit& u, int wr, int wc, int fr, int fq) const {
        const int row0 = u.pm * BM + wr * 64 + fr, col0 = u.pn * HALF + wc * 32 + 8 * fq;
#pragma unroll
        for (int ai = 0; ai < 2; ++ai)
#pragma unroll
            for (int m = 0; m < 4; ++m) {
                bf16_t* p = H + (size_t)(row0 + ai * HALF + m * 16) * ldh + col0;
                const f32x4 g0 = acc[ai][0][m][0], g1 = acc[ai][0][m][1], u0 = acc[ai][1][m][0], u1 = acc[ai][1][m][1];
                float h[8];
#pragma unroll
                for (int i = 0; i < 4; ++i) { h[i] = fsilu(g0[i]) * u0[i]; h[4 + i] = fsilu(g1[i]) * u1[i]; }
                u32x4 w; w.x = cvt_pk_bf16(h[0], h[1]); w.y = cvt_pk_bf16(h[2], h[3]); w.z = cvt_pk_bf16(h[4], h[5]); w.w = cvt_pk_bf16(h[6], h[7]);
                *(u32x4*)p = w;
            }
    }
};

struct EpiResid {
    static constexpr bool PERM = false, AFTER_DRAIN = false;
    const float* resP; const float* resS; float* out; float alpha, scale;
    __device__ __forceinline__ void operator()(const f32x4 (&acc)[2][2][4][2], const Unit& u, int wr, int wc, int fr, int fq) const {
        const int row0 = u.pm * BM + wr * 64 + fr, col0 = u.pn * BM + wc * 32 + 4 * fq;
#pragma unroll
        for (int ai = 0; ai < 2; ++ai)
#pragma unroll
            for (int m = 0; m < 4; ++m) {
                const int row = row0 + ai * HALF + m * 16;
                const float* rb = (row < 16384) ? resP + (size_t)row * 1024 : resS + (size_t)(row - 16384) * 1024;
                float* ob = out + (size_t)row * 1024;
#pragma unroll
                for (int bj = 0; bj < 2; ++bj)
#pragma unroll
                    for (int n = 0; n < 2; ++n) { const int col = col0 + bj * HALF + n * 16;
                        const f32x4 r = *(const f32x4*)(rb + col); *(f32x4*)(ob + col) = r * alpha + acc[ai][bj][m][n] * scale; }
            }
    }
};

struct EpiWin {
    static constexpr bool PERM = false, AFTER_DRAIN = false;
    bf16_t *Qb, *Kb, *Vb; float *HQ, *LOGF, *KH, *HI, *HG; const float *COS, *SIN, *LB;
    float *okp, *ovp, *oks, *ovs;
    __device__ __forceinline__ float* kvdst(float* op, float* os, int row) const {
        if (row < 16384) { const int t = row & 4095, b = row >> 12; return (t >= 2048) ? op + (size_t)(b * 2048 + (t - 2048)) * 512 : (float*)nullptr; }
        const int r = row - 16384; return os + (size_t)((r >> 2) * 2048 + 2044 + (r & 3)) * 512;
    }
    __device__ __forceinline__ void operator()(const f32x4 (&acc)[2][2][4][2], const Unit& u, int wr, int wc, int fr, int fq) const {
        const int typ = u.pn >> 1, cbase = (u.pn & 1) * 256;
        const int row0 = u.pm * BM + wr * 64 + fr;
        if (typ <= 1) {
            bf16_t* dstb = typ == 0 ? Qb : Kb;
            const int e0 = 16 * (wc & 1) + 4 * fq;
#pragma unroll
            for (int ai = 0; ai < 2; ++ai)
#pragma unroll
                for (int m = 0; m < 4; ++m) {
                    const int row = row0 + ai * HALF + m * 16;
                    const int pi = (row < 16384) ? (row & 4095) : 4096 + ((row - 16384) & 3);
                    const f32x4 cs = *(const f32x4*)(COS + pi * 32 + e0), sn = *(const f32x4*)(SIN + pi * 32 + e0);
                    float* fo = (typ == 1) ? kvdst(okp, oks, row) : (float*)nullptr;
#pragma unroll
                    for (int bj = 0; bj < 2; ++bj) {
                        const int hh = (u.pn & 1) * 4 + 2 * bj + (wc >> 1);
                        const f32x4 x1 = acc[ai][bj][m][0], x2 = acc[ai][bj][m][1];
                        const f32x4 o1 = x1 * cs - x2 * sn, o2 = x2 * cs + x1 * sn;
                        bf16_t* pb = dstb + (size_t)row * 512 + hh * 64 + e0;
                        u32x2 w1, w2; w1.x = cvt_pk_bf16(o1[0], o1[1]); w1.y = cvt_pk_bf16(o1[2], o1[3]); w2.x = cvt_pk_bf16(o2[0], o2[1]); w2.y = cvt_pk_bf16(o2[2], o2[3]);
                        *(u32x2*)pb = w1; *(u32x2*)(pb + 32) = w2;
                        if (fo) { *(f32x4*)(fo + hh * 64 + e0) = o1; *(f32x4*)(fo + hh * 64 + e0 + 32) = o2; }
                    }
                }
        } else {
#pragma unroll
            for (int ai = 0; ai < 2; ++ai)
#pragma unroll
                for (int m = 0; m < 4; ++m) {
                    const int row = row0 + ai * HALF + m * 16;
                    float* fo = (typ == 2) ? kvdst(ovp, ovs, row) : (float*)nullptr;
#pragma unroll
                    for (int bj = 0; bj < 2; ++bj)
#pragma unroll
                        for (int n = 0; n < 2; ++n) {
                            const int col = cbase + bj * HALF + wc * 32 + n * 16 + 4 * fq;
                            const f32x4 z = acc[ai][bj][m][n];
                            const size_t off = (size_t)row * 512 + col;
                            if (typ == 2) {
                                u32x2 w; w.x = cvt_pk_bf16(z[0], z[1]); w.y = cvt_pk_bf16(z[2], z[3]); *(u32x2*)(Vb + off) = w;
                                if (fo) *(f32x4*)(fo + col) = z;
                            } else if (typ == 3) {
                                f32x4 o; for (int i = 0; i < 4; ++i) o[i] = fsilu(z[i]); *(f32x4*)(HQ + off) = o;
                            } else if (typ == 4) {
                                const f32x4 lb = *(const f32x4*)(LB + col); f32x4 lf, kh;
                                for (int i = 0; i < 4; ++i) { const float sg = fsig(z[i]), sm = fsig(-z[i]); lf[i] = __logf(lb[i] + (1.0f - lb[i]) * sg); kh[i] = (1.0f - lb[i]) * sm; }
                                *(f32x4*)(LOGF + off) = lf; *(f32x4*)(KH + off) = kh;
                            } else if (typ == 5) {
                                *(f32x4*)(HI + off) = z;
                            } else {
                                f32x4 o; for (int i = 0; i < 4; ++i) o[i] = fsilu(z[i]); *(f32x4*)(HG + off) = o;
                            }
                        }
                }
        }
    }
};

template <class Epi, class Sched, bool ALIGN_EPI = false, bool SP2 = false>
__device__ __forceinline__ void gemm_phase(PG8_LAS unsigned char* lds, const Gemm g, const Sched& S, const Epi& E, int tid_in) {
    int tid_o = tid_in; asm volatile("" : "+v"(tid_o));
    const int tid = tid_o, wid = __builtin_amdgcn_readfirstlane(tid >> 6), lane = tid & 63, wr = wid >> 2, wc = wid & 3, fr = lane & 15, fq = lane >> 4;
    const int K = g.K, nt = K / BK;
    unsigned voffA[2], voffB[2];
#pragma unroll
    for (int i = 0; i < 2; ++i) { int R, C; stage_rc(tid * 16 + i * 8192, R, C); const int Rb = Epi::PERM ? ((R & ~31) + perm32(R & 31)) : R;
        voffA[i] = (unsigned)(R * K + C) * 2u; voffB[i] = (unsigned)(Rb * K + C) * 2u; }
    const size_t kstep = (size_t)(BK * 2);
    const size_t hstep = (size_t)HALF * K * 2;
    const size_t tstep = 2 * hstep;
    const unsigned ldsw = (unsigned)wid * 1024u;
    const int aoff = lds_byte(wr * 64 + fr, fq * 8), boff = lds_byte(wc * 32 + fr, fq * 8);
#define PG8_SA(b, h) (((b) * 2 + (h)) * HTB)
#define PG8_SB(b, h) ((4 + (b) * 2 + (h)) * HTB)
#define PG8_STAGE(bufoff, gbase, voff) do { _Pragma("unroll") for (int _i = 0; _i < 2; ++_i) \
        __builtin_amdgcn_global_load_lds((const unsigned*)((const char*)(gbase) + (voff)[_i]), (PG8_LAS unsigned*)(lds + (bufoff) + ldsw + _i * 8192), 16, 0, 0); } while (0)
#define PG8_LDA(dst, b, h) do { _Pragma("unroll") for (int m = 0; m < 4; ++m) _Pragma("unroll") for (int k = 0; k < 2; ++k) dst[m][k] = *(const PG8_LAS bf16x8*)(lds + PG8_SA(b, h) + aoff + m * 2048 + k * 1024); } while (0)
#define PG8_LDB(dst, b, h) do { _Pragma("unroll") for (int n = 0; n < 2; ++n) _Pragma("unroll") for (int k = 0; k < 2; ++k) dst[n][k] = *(const PG8_LAS bf16x8*)(lds + PG8_SB(b, h) + boff + n * 2048 + k * 1024); } while (0)
#define PG8_MMA(ai, bj, At, Bt) do { __builtin_amdgcn_s_setprio(1); _Pragma("unroll") for (int m = 0; m < 4; ++m) _Pragma("unroll") for (int n = 0; n < 2; ++n) _Pragma("unroll") for (int k = 0; k < 2; ++k) \
        acc[ai][bj][m][n] = __builtin_amdgcn_mfma_f32_16x16x32_bf16(Bt[n][k], At[m][k], acc[ai][bj][m][n], 0, 0, 0); __builtin_amdgcn_s_setprio(0); } while (0)
#define PG8_WAIT_V(n) asm volatile("s_waitcnt vmcnt(" #n ")" ::: "memory")
#define PG8_WAIT_L(n) asm volatile("s_waitcnt lgkmcnt(" #n ")" ::: "memory")
#define PG8_BAR __builtin_amdgcn_s_barrier()
#define PG8_SCHED __builtin_amdgcn_sched_barrier(0)
    Unit cur, nxt; int ui = 0;
    if (!S.next(0, cur)) return;
    f32x4 acc[2][2][4][2];
#pragma unroll
    for (int a = 0; a < 2; ++a)
#pragma unroll
        for (int b = 0; b < 2; ++b)
#pragma unroll
            for (int m = 0; m < 4; ++m)
#pragma unroll
                for (int n = 0; n < 2; ++n) acc[a][b][m][n] = (f32x4){0.f, 0.f, 0.f, 0.f};
    bf16x8 At[4][2], B0[2][2], B1[2][2];
    const char* cA = (const char*)g.A + (size_t)cur.pm * tstep; const char* cB = (const char*)g.Bt + (size_t)cur.pn * tstep;
    S.a_ready(cur);
    if constexpr (SP2) {
        PG8_STAGE(PG8_SB(0, 0), cB, voffB); PG8_STAGE(PG8_SB(0, 1), cB + hstep, voffB); PG8_STAGE(PG8_SA(0, 0), cA, voffA); PG8_STAGE(PG8_SA(0, 1), cA + hstep, voffA);
        if (wr == 1) PG8_BAR;
        PG8_WAIT_V(2); PG8_BAR;
        PG8_STAGE(PG8_SB(1, 0), cB + kstep, voffB); PG8_STAGE(PG8_SA(1, 0), cA + kstep, voffA); PG8_STAGE(PG8_SB(1, 1), cB + hstep + kstep, voffB);
        PG8_WAIT_V(6); PG8_BAR;
    } else {
        PG8_STAGE(PG8_SB(0, 0), cB, voffB); PG8_STAGE(PG8_SA(0, 0), cA, voffA); PG8_STAGE(PG8_SB(0, 1), cB + hstep, voffB); PG8_STAGE(PG8_SA(0, 1), cA + hstep, voffA);
        if (wr == 1) PG8_BAR;
        PG8_WAIT_V(4); PG8_BAR;
        PG8_STAGE(PG8_SB(1, 0), cB + kstep, voffB); PG8_STAGE(PG8_SA(1, 0), cA + kstep, voffA); PG8_STAGE(PG8_SB(1, 1), cB + hstep + kstep, voffB);
        PG8_WAIT_V(6); PG8_BAR;
    }
    for (;;) {
        const bool has_next = S.next(ui + 1, nxt);
        const char* nA = has_next ? (const char*)g.A + (size_t)nxt.pm * tstep : cA; const char* nB = has_next ? (const char*)g.Bt + (size_t)nxt.pn * tstep : cB;
        for (int t = 0; t < nt; t += 2) {
            const bool last = (t == nt - 2);
            const char* a1 = cA + (size_t)(t + 1) * kstep;
            const char* a2 = last ? nA : cA + (size_t)(t + 2) * kstep; const char* b2 = last ? nB : cB + (size_t)(t + 2) * kstep;
            const char* a3 = a2 + kstep; const char* b3 = b2 + kstep;
            if (last && has_next) S.a_ready(nxt);
            if constexpr (SP2) {
            PG8_LDB(B0, 0, 0); PG8_LDB(B1, 0, 1); PG8_SCHED; PG8_LDA(At, 0, 0); PG8_STAGE(PG8_SA(1, 1), a1 + hstep, voffA);
            PG8_WAIT_V(8); PG8_WAIT_L(0); PG8_BAR; PG8_MMA(0, 0, At, B0); PG8_MMA(0, 1, At, B1); PG8_BAR; PG8_SCHED;
            PG8_LDA(At, 0, 1); PG8_STAGE(PG8_SB(0, 0), b2, voffB); PG8_STAGE(PG8_SB(0, 1), b2 + hstep, voffB); PG8_STAGE(PG8_SA(0, 0), a2, voffA);
            PG8_WAIT_V(8); PG8_WAIT_L(0); PG8_BAR; PG8_MMA(1, 0, At, B0); PG8_MMA(1, 1, At, B1); PG8_BAR; PG8_SCHED;
            PG8_LDB(B0, 1, 0); PG8_LDB(B1, 1, 1); PG8_SCHED; PG8_LDA(At, 1, 0); PG8_STAGE(PG8_SA(0, 1), a2 + hstep, voffA);
            PG8_WAIT_V(8); PG8_WAIT_L(0); PG8_BAR; PG8_MMA(0, 0, At, B0); PG8_MMA(0, 1, At, B1); PG8_BAR; PG8_SCHED;
            PG8_LDA(At, 1, 1); PG8_STAGE(PG8_SB(1, 0), b3, voffB); PG8_STAGE(PG8_SB(1, 1), b3 + hstep, voffB); PG8_STAGE(PG8_SA(1, 0), a3, voffA);
            PG8_WAIT_V(8); PG8_WAIT_L(0); PG8_BAR; PG8_MMA(1, 0, At, B0); PG8_MMA(1, 1, At, B1); PG8_BAR; PG8_SCHED;
            } else {
            PG8_LDB(B0, 0, 0); PG8_SCHED; PG8_LDA(At, 0, 0); PG8_STAGE(PG8_SA(1, 1), a1 + hstep, voffA);
            PG8_WAIT_L(8); PG8_BAR; PG8_WAIT_L(0); PG8_MMA(0, 0, At, B0); PG8_BAR; PG8_SCHED;
            PG8_LDB(B1, 0, 1); PG8_STAGE(PG8_SB(0, 0), b2, voffB);
            PG8_BAR; PG8_WAIT_L(0); PG8_MMA(0, 1, At, B1); PG8_BAR;
            PG8_LDA(At, 0, 1); PG8_STAGE(PG8_SA(0, 0), a2, voffA);
            PG8_BAR; PG8_WAIT_L(0); PG8_MMA(1, 0, At, B0); PG8_BAR; PG8_SCHED;
            PG8_STAGE(PG8_SB(0, 1), b2 + hstep, voffB);
            PG8_WAIT_V(6); PG8_BAR; PG8_MMA(1, 1, At, B1); PG8_BAR;
            PG8_LDB(B0, 1, 0); PG8_SCHED; PG8_LDA(At, 1, 0); PG8_STAGE(PG8_SA(0, 1), a2 + hstep, voffA);
            PG8_WAIT_L(8); PG8_BAR; PG8_WAIT_L(0); PG8_MMA(0, 0, At, B0); PG8_BAR; PG8_SCHED;
            PG8_LDB(B1, 1, 1); PG8_STAGE(PG8_SB(1, 0), b3, voffB);
            PG8_BAR; PG8_WAIT_L(0); PG8_MMA(0, 1, At, B1); PG8_BAR;
            PG8_LDA(At, 1, 1); PG8_STAGE(PG8_SA(1, 0), a3, voffA);
            PG8_BAR; PG8_WAIT_L(0); PG8_MMA(1, 0, At, B0); PG8_BAR; PG8_SCHED;
            PG8_STAGE(PG8_SB(1, 1), b3 + hstep, voffB);
            PG8_WAIT_V(6); PG8_BAR; PG8_MMA(1, 1, At, B1); PG8_BAR;
            }
        }
        if constexpr (ALIGN_EPI) { if (wr == 0) PG8_BAR; }
        if constexpr (!Epi::AFTER_DRAIN) { E(acc, cur, wr, wc, fr, fq); S.done(cur); }
        if (!has_next) break;
#pragma unroll
        for (int a = 0; a < 2; ++a)
#pragma unroll
            for (int b = 0; b < 2; ++b)
#pragma unroll
                for (int m = 0; m < 4; ++m)
#pragma unroll
                    for (int n = 0; n < 2; ++n) acc[a][b][m][n] = (f32x4){0.f, 0.f, 0.f, 0.f};
        cur = nxt; cA = nA; cB = nB; ++ui;
        if constexpr (ALIGN_EPI) { if (wr == 1) PG8_BAR; }
    }
    PG8_WAIT_V(0);
    if constexpr (!ALIGN_EPI) { if (wr == 0) PG8_BAR; }
    PG8_BAR;
    if constexpr (Epi::AFTER_DRAIN) { E.fused(acc, cur, wr, wc, fr, fq, lds, wid, lane); S.done(cur); }
#undef PG8_SA
#undef PG8_SB
#undef PG8_STAGE
#undef PG8_LDA
#undef PG8_LDB
#undef PG8_MMA
#undef PG8_WAIT_V
#undef PG8_WAIT_L
#undef PG8_BAR
#undef PG8_SCHED
}
}
#define GAS __attribute__((address_space(1)))
#define LAS __attribute__((address_space(3)))
typedef unsigned short bf16;
typedef unsigned v4u __attribute__((ext_vector_type(4)));
typedef float f32x4 __attribute__((ext_vector_type(4)));
typedef short bf16x8 __attribute__((ext_vector_type(8)));
typedef GAS unsigned gu32;
typedef GAS unsigned long long gu64;
#define RLX_AGENT __ATOMIC_RELAXED, __HIP_MEMORY_SCOPE_AGENT
#define LDS_WAIT() asm volatile("s_waitcnt lgkmcnt(0)" ::: "memory")
#define VM_WAIT() asm volatile("s_waitcnt vmcnt(0)" ::: "memory")
__device__ __forceinline__ unsigned long long rt() { return __builtin_amdgcn_s_memrealtime(); }
__device__ __forceinline__ unsigned f2bf(float f) { unsigned u = __builtin_bit_cast(unsigned, f); return (u + 0x7fffu + ((u >> 16) & 1u)) >> 16; }
__device__ __forceinline__ unsigned pk2(float lo, float hi) { return f2bf(lo) | (f2bf(hi) << 16); }

#define XB_TMO      128
#define XB_XCNT(j)  (256  + 64 * (j))
#define XB_XSUB(j)  (1280 + 64 * (j))
#define XB_XGEN(j)  (2304 + 64 * (j))
#define XB_TOP      3328
#define XB_TOPGEN   3392
#define XCD_BAR_WORDS 3456
#define XB_SPIN_CAP (1u << 18)

__device__ __forceinline__ unsigned xb_ld(unsigned* p)              { return __hip_atomic_load(p, __ATOMIC_RELAXED, __HIP_MEMORY_SCOPE_AGENT); }
__device__ __forceinline__ unsigned xb_add(unsigned* p, unsigned v) { return __hip_atomic_fetch_add(p, v, __ATOMIC_RELAXED, __HIP_MEMORY_SCOPE_AGENT); }
__device__ __forceinline__ unsigned xb_xcc_id() { return (unsigned)__builtin_amdgcn_s_getreg((3 << 11) | 20) & 0xFu; }
#define XB_SPIN(cond, bar) do { unsigned _sp = 0; while (cond) { __builtin_amdgcn_s_sleep(1); \
    if ((++_sp & 255u) == 0u) { if (xb_ld(&(bar)[XB_TMO])) break; if (_sp > XB_SPIN_CAP) { atomicAdd(&(bar)[XB_TMO], 1u); break; } } } } while (0)

struct XcdBarrier {
    unsigned* bar; unsigned x;
    volatile LAS unsigned* st;
};

__device__ __forceinline__ XcdBarrier xcd_barrier_post(unsigned* bar, volatile LAS unsigned* st) {
    XcdBarrier b; b.bar = bar; b.x = xb_xcc_id(); b.st = st;
    if (threadIdx.x == 0) (void)xb_add(&bar[XB_XCNT(b.x)], 1u);
    return b;
}
__device__ __forceinline__ void xcd_barrier_complete(unsigned* bar, unsigned x, unsigned& nloc, unsigned& nx) {
    const unsigned G = gridDim.x * gridDim.y * gridDim.z;
    unsigned sum, cnt, mine, sp = 0u;
    for (;;) {
        sum = 0u; cnt = 0u; mine = 0u;
#pragma unroll
        for (unsigned j = 0; j < 16; ++j) { const unsigned c = xb_ld(&bar[XB_XCNT(j)]); sum += c; cnt += (c > 0u) ? 1u : 0u; mine = (j == x) ? c : mine; }
        if (sum == G) break;
        __builtin_amdgcn_s_sleep(1);
        if ((++sp & 255u) == 0u) { if (xb_ld(&bar[XB_TMO])) break; if (sp > XB_SPIN_CAP) { atomicAdd(&bar[XB_TMO], 1u); break; } }
    }
    nloc = mine > 0u ? mine : 1u; nx = cnt > 0u ? cnt : 1u;
}

__device__ __forceinline__ void xcd_barrier(const XcdBarrier& b) {
    asm volatile("s_waitcnt vmcnt(0)" ::: "memory");
    __syncthreads();
    if (threadIdx.x == 0) {
        unsigned* bar = b.bar;
        __builtin_amdgcn_s_waitcnt(0);
        unsigned nloc = b.st[0], nx = b.st[1];
        if (nloc == 0u) { xcd_barrier_complete(bar, b.x, nloc, nx); b.st[0] = nloc; b.st[1] = nx; }
        const unsigned old = xb_add(&bar[XB_XSUB(b.x)], 1u);
        const unsigned gen = old / nloc;
        if (old + 1u == (gen + 1u) * nloc) {
            __builtin_amdgcn_fence(__ATOMIC_RELEASE, "agent");
            asm volatile("s_waitcnt vmcnt(0)" ::: "memory");
            const unsigned og = xb_add(&bar[XB_TOP], 1u);
            const unsigned tg = og / nx;
            if (og + 1u == (tg + 1u) * nx) xb_add(&bar[XB_TOPGEN], 1u);
            else XB_SPIN(xb_ld(&bar[XB_TOPGEN]) == tg, bar);
            __builtin_amdgcn_fence(__ATOMIC_ACQUIRE, "agent");
            xb_add(&bar[XB_XGEN(b.x)], 1u);
            asm volatile("s_waitcnt vmcnt(0)" ::: "memory");
        } else {
            XB_SPIN(xb_ld(&bar[XB_XGEN(b.x)]) == gen, bar);
            __builtin_amdgcn_fence(__ATOMIC_ACQUIRE, "agent");
            asm volatile("s_waitcnt vmcnt(0)" ::: "memory");
        }
    }
    __syncthreads();
}
constexpr int NWAVES = 8;
constexpr int D = 1024, MP = 16384, MS = 512, M = MP + MS, FF = 2816, NGU = 2 * FF, NIN = 3584, SEQ = 4096;
constexpr float LN_EPS = 1e-5f;
constexpr float DN_ALPHA = 1.189207115002721f;
constexpr size_t MiB = 1u << 20;
constexpr size_t WS_CTL = 0, CTL_ZERO_BYTES = 1 * MiB;
constexpr size_t WS_COS = 1 * MiB, WS_SIN = 1 * MiB + 640 * 1024, WS_LB = 1 * MiB + 1280 * 1024;
constexpr size_t WS_W1GU = 4 * MiB, WS_W1D = 15 * MiB, WS_WIN = 21 * MiB, WS_WOUT = 28 * MiB, WS_W2GU = 30 * MiB, WS_W2D = 41 * MiB;
constexpr size_t WS_XB = 48 * MiB, WS_X1B = 82 * MiB, WS_X2B = 116 * MiB, WS_H = 150 * MiB, WS_YPRE = 242 * MiB, WS_X1 = 308 * MiB, WS_X2 = 374 * MiB;
constexpr size_t WS_QB = 440 * MiB, WS_KB = 457 * MiB, WS_VB = 474 * MiB, WS_HQ = 491 * MiB, WS_LOGF = 524 * MiB, WS_KH = 557 * MiB, WS_HI = 590 * MiB, WS_HG = 623 * MiB;
constexpr size_t WS_CAT = 656 * MiB, WS_OPART = 689 * MiB, WS_LSE = 785 * MiB, WS_USEG = 787 * MiB, WS_DSEG = 803 * MiB, WS_DBG = 804 * MiB, WS_END = 806 * MiB;
static_assert(WS_W1GU + (size_t)NGU * D * 2 <= WS_W1D && WS_W1D + (size_t)D * FF * 2 <= WS_WIN && WS_WIN + (size_t)NIN * D * 2 <= WS_WOUT && WS_WOUT + (size_t)D * D * 2 <= WS_W2GU, "ws map (weights)");
static_assert(WS_XB + (size_t)M * D * 2 <= WS_X1B && WS_H + (size_t)M * FF * 2 <= WS_YPRE && WS_YPRE + (size_t)M * D * 4 <= WS_X1 && WS_X2 + (size_t)M * D * 4 <= WS_QB, "ws map (activations)");
static_assert(WS_QB + (size_t)M * 512 * 2 <= WS_KB && WS_HQ + (size_t)M * 512 * 4 <= WS_LOGF && WS_OPART + (size_t)3 * MP * 512 * 4 <= WS_LSE && WS_USEG + (size_t)256 * 65536 <= WS_DSEG, "ws map (mixer)");
constexpr int CW_BAR = 4096;
constexpr size_t O_YP = 0, O_YS = 16777216, O_KP = O_YS + 524288, O_VP = O_KP + 4194304, O_SP = O_VP + 4194304, O_KS = O_SP + 262144, O_VS = O_KS + 134217728, O_SS = O_VS + 134217728, O_END = O_SS + 8388608;
constexpr int RING_OFF = 0, RING_BYTES = 131072, LDSCTL_OFF = RING_BYTES, MISC_OFF = LDSCTL_OFF + 320, LDS_BYTES = 147456;

__constant__ float INV_FREQ[32] = {1.000000000e+00f, 7.498942614e-01f, 5.623413324e-01f, 4.216965139e-01f, 3.162277639e-01f, 2.371373773e-01f, 1.778279394e-01f, 1.333521307e-01f, 1.000000015e-01f, 7.498941571e-02f, 5.623413250e-02f, 4.216965288e-02f, 3.162277490e-02f, 2.371373773e-02f, 1.778279431e-02f, 1.333521493e-02f, 9.999999776e-03f, 7.498941850e-03f, 5.623413250e-03f, 4.216964822e-03f, 3.162277630e-03f, 2.371373586e-03f, 1.778279431e-03f, 1.333521446e-03f, 1.000000047e-03f, 7.498942432e-04f, 5.623413017e-04f, 4.216965172e-04f, 3.162277571e-04f, 2.371373703e-04f, 1.778279402e-04f, 1.333521504e-04f};

typedef unsigned u32x2 __attribute__((ext_vector_type(2)));
typedef unsigned short u16;
struct Ctx {
    LAS unsigned char* lds;
    int tid, lane, wave, G, bid;
    const float *xp, *xs, *ck, *cv, *st0, *w1g, *w1u, *w1d, *ln1g, *ln1b, *win, *hlb, *hng, *wout, *ln2g, *ln2b, *w2g, *w2u, *w2d, *ln3g, *ln3b;
    float* out; unsigned char* ws;
    __device__ __forceinline__ bf16* W1gu() const { return (bf16*)(ws + WS_W1GU); }
    __device__ __forceinline__ bf16* W1d() const { return (bf16*)(ws + WS_W1D); }
    __device__ __forceinline__ bf16* Win() const { return (bf16*)(ws + WS_WIN); }
    __device__ __forceinline__ bf16* Wout() const { return (bf16*)(ws + WS_WOUT); }
    __device__ __forceinline__ bf16* W2gu() const { return (bf16*)(ws + WS_W2GU); }
    __device__ __forceinline__ bf16* W2d() const { return (bf16*)(ws + WS_W2D); }
    __device__ __forceinline__ bf16* Xb() const { return (bf16*)(ws + WS_XB); }
    __device__ __forceinline__ bf16* X1b() const { return (bf16*)(ws + WS_X1B); }
    __device__ __forceinline__ bf16* X2b() const { return (bf16*)(ws + WS_X2B); }
    __device__ __forceinline__ bf16* Hb() const { return (bf16*)(ws + WS_H); }
    __device__ __forceinline__ bf16* Qb() const { return (bf16*)(ws + WS_QB); }
    __device__ __forceinline__ bf16* Kb() const { return (bf16*)(ws + WS_KB); }
    __device__ __forceinline__ bf16* Vb() const { return (bf16*)(ws + WS_VB); }
    __device__ __forceinline__ bf16* Cat() const { return (bf16*)(ws + WS_CAT); }
    __device__ __forceinline__ float* Ypre() const { return (float*)(ws + WS_YPRE); }
    __device__ __forceinline__ float* X1() const { return (float*)(ws + WS_X1); }
    __device__ __forceinline__ float* X2() const { return (float*)(ws + WS_X2); }
    __device__ __forceinline__ float* HQ() const { return (float*)(ws + WS_HQ); }
    __device__ __forceinline__ float* LOGF() const { return (float*)(ws + WS_LOGF); }
    __device__ __forceinline__ float* KH() const { return (float*)(ws + WS_KH); }
    __device__ __forceinline__ float* HI() const { return (float*)(ws + WS_HI); }
    __device__ __forceinline__ float* HG() const { return (float*)(ws + WS_HG); }
    __device__ __forceinline__ float* COS() const { return (float*)(ws + WS_COS); }
    __device__ __forceinline__ float* SIN() const { return (float*)(ws + WS_SIN); }
    __device__ __forceinline__ float* LB() const { return (float*)(ws + WS_LB); }
    __device__ __forceinline__ float* Opart() const { return (float*)(ws + WS_OPART); }
    __device__ __forceinline__ float* Lse() const { return (float*)(ws + WS_LSE); }
    __device__ __forceinline__ float* Useg() const { return (float*)(ws + WS_USEG); }
    __device__ __forceinline__ float* Dseg() const { return (float*)(ws + WS_DSEG); }
};
__device__ __forceinline__ float wave_sum(float v) {
#pragma unroll
    for (int o = 1; o < 64; o <<= 1) v += __shfl_xor(v, o);
    return v;
}
__device__ __forceinline__ float bf2f(unsigned h) { return __builtin_bit_cast(float, h << 16); }

struct RmNat { __device__ __forceinline__ int operator()(int c) const { return c; } };
struct RmGate { __device__ __forceinline__ int operator()(int c) const { return 256 * (c >> 7) + (c & 127); } };
struct RmUp { __device__ __forceinline__ int operator()(int c) const { return 256 * (c >> 7) + 128 + (c & 127); } };
struct RmWin { __device__ __forceinline__ int operator()(int c) const { if (c >= 1024) return c; const int j = c & 63; return (c & ~63) | (j & 15) | (((j >> 4) & 1) << 5) | (((j >> 5) & 1) << 4); } };
template <class RM>
__device__ __forceinline__ void p0_transpose_item(const float* W, int K, int N, bf16* WT, RM rm, LAS float* scr, int item, int lane) {
    const int nblk = N / 32, kb = item / nblk, nb = item % nblk, k0 = 64 * kb, n0 = 32 * nb;
#pragma unroll 8
    for (int i = 0; i < 32; ++i) { const int kk = 2 * i + (lane >> 5); scr[kk * 33 + (lane & 31)] = W[(size_t)(k0 + kk) * N + n0 + (lane & 31)]; }
    LDS_WAIT(); asm volatile("" ::: "memory");
    const int c = lane & 7;
#pragma unroll
    for (int j = 0; j < 4; ++j) { const int n = (lane >> 3) + 8 * j; const LAS float* s = scr + (8 * c) * 33 + n;
        v4u o; o.x = pk2(s[0 * 33], s[1 * 33]); o.y = pk2(s[2 * 33], s[3 * 33]); o.z = pk2(s[4 * 33], s[5 * 33]); o.w = pk2(s[6 * 33], s[7 * 33]);
        *(GAS v4u*)(WT + (size_t)rm(n0 + n) * K + k0 + 8 * c) = o; }
    LDS_WAIT(); asm volatile("" ::: "memory");
}
__device__ __forceinline__ void p0_prologue(const Ctx& F) {
    LAS float* scr = (LAS float*)(F.lds + RING_OFF + F.wave * 16384);
    const int gw = F.bid * NWAVES + F.wave, NGW = F.G * NWAVES;
    constexpr int I_G = (D / 64) * (FF / 32), I_D = (FF / 64) * (D / 32), I_IN = (D / 64) * (NIN / 32), I_O = (D / 64) * (D / 32);
    constexpr int NITEMS = 6 * I_G + I_IN + I_O; static_assert(I_G == I_D, "item counts");
    for (int it = gw; it < NITEMS; it += NGW) {
        int r = it;
        if (r < I_G) { p0_transpose_item(F.w1g, D, FF, F.W1gu(), RmGate(), scr, r, F.lane); continue; } r -= I_G;
        if (r < I_G) { p0_transpose_item(F.w1u, D, FF, F.W1gu(), RmUp(), scr, r, F.lane); continue; } r -= I_G;
        if (r < I_D) { p0_transpose_item(F.w1d, FF, D, F.W1d(), RmNat(), scr, r, F.lane); continue; } r -= I_D;
        if (r < I_G) { p0_transpose_item(F.w2g, D, FF, F.W2gu(), RmGate(), scr, r, F.lane); continue; } r -= I_G;
        if (r < I_G) { p0_transpose_item(F.w2u, D, FF, F.W2gu(), RmUp(), scr, r, F.lane); continue; } r -= I_G;
        if (r < I_D) { p0_transpose_item(F.w2d, FF, D, F.W2d(), RmNat(), scr, r, F.lane); continue; } r -= I_D;
        if (r < I_IN) { p0_transpose_item(F.win, D, NIN, F.Win(), RmWin(), scr, r, F.lane); continue; } r -= I_IN;
        p0_transpose_item(F.wout, D, D, F.Wout(), RmNat(), scr, r, F.lane);
    }
    for (int m = gw; m < M; m += NGW) {
        const float* xr = (m < MP) ? F.xp + (size_t)m * D : F.xs + (size_t)(m - MP) * D;
        const GAS f32x4* xv = (const GAS f32x4*)xr + F.lane; GAS unsigned long long* o8 = (GAS unsigned long long*)(F.Xb() + (size_t)m * D) + F.lane;
#pragma unroll
        for (int j = 0; j < 4; ++j) { const f32x4 v = xv[64 * j]; o8[64 * j] = (unsigned long long)pk2(v.x, v.y) | ((unsigned long long)pk2(v.z, v.w) << 32); }
    }
    for (int idx = F.bid * 512 + F.tid; idx < 4100 * 32; idx += F.G * 512) {
        const int pi = idx >> 5, i = idx & 31; const int pos = pi < 4096 ? pi : 8192 + (pi - 4096);
        const float ang = (float)pos * INV_FREQ[i];
        double rev = (double)ang * 0.15915494309189535; rev -= __builtin_rint(rev);
        const float rf = (float)rev;
        F.COS()[idx] = __builtin_amdgcn_cosf(rf); F.SIN()[idx] = __builtin_amdgcn_sinf(rf);
    }
    if (F.bid == 0) { const int c = F.tid; const float a0 = F.hlb[c], a1 = F.hlb[512 + c]; const float mx = fmaxf(a0, a1); const float e0 = __expf(a0 - mx), e1 = __expf(a1 - mx); F.LB()[c] = e0 / (e0 + e1); }
    {
        constexpr size_t PER_B = (size_t)2044 * 512 / 4;
        const size_t nth = (size_t)F.G * 512;
        for (size_t i = (size_t)F.bid * 512 + F.tid; i < 128 * PER_B; i += nth) {
            const size_t b = i / PER_B, r = i - b * PER_B;
            const f32x4 a = __builtin_nontemporal_load((const f32x4*)(F.ck + b * 1048576 + 2048) + r);
            const f32x4 c = __builtin_nontemporal_load((const f32x4*)(F.cv + b * 1048576 + 2048) + r);
            __builtin_nontemporal_store(a, (f32x4*)(F.out + O_KS + b * 1048576) + r);
            __builtin_nontemporal_store(c, (f32x4*)(F.out + O_VS + b * 1048576) + r);
        }
    }
}
__device__ __forceinline__ void ln_rows(const Ctx& F, const float* pre, const float* gam, const float* bet, float* outf, bf16* outb) {
    const int gw = F.bid * NWAVES + F.wave, NGW = F.G * NWAVES;
    f32x4 gv[4], bv[4];
#pragma unroll
    for (int j = 0; j < 4; ++j) { gv[j] = ((const f32x4*)gam)[F.lane + 64 * j]; bv[j] = ((const f32x4*)bet)[F.lane + 64 * j]; }
    for (int m = gw; m < M; m += NGW) {
        const f32x4* xr = (const f32x4*)(pre + (size_t)m * D) + F.lane;
        f32x4 v[4]; float s = 0.f;
#pragma unroll
        for (int j = 0; j < 4; ++j) { v[j] = xr[64 * j]; s += (v[j].x + v[j].y) + (v[j].z + v[j].w); }
        const float mean = wave_sum(s) * (1.f / D); float s2 = 0.f;
#pragma unroll
        for (int j = 0; j < 4; ++j) { v[j] = v[j] - mean; s2 += (v[j].x * v[j].x + v[j].y * v[j].y) + (v[j].z * v[j].z + v[j].w * v[j].w); }
        const float rstd = 1.f / sqrtf(wave_sum(s2) * (1.f / D) + LN_EPS);
#pragma unroll
        for (int j = 0; j < 4; ++j) { const f32x4 y = v[j] * rstd * gv[j] + bv[j];
            ((f32x4*)(outf + (size_t)m * D))[F.lane + 64 * j] = y;
            if (outb) ((unsigned long long*)(outb + (size_t)m * D))[F.lane + 64 * j] = (unsigned long long)pk2(y.x, y.y) | ((unsigned long long)pk2(y.z, y.w) << 32); }
    }
}
typedef float f32x4v __attribute__((ext_vector_type(4)));
#define MFMA16(a, b, c) __builtin_amdgcn_mfma_f32_16x16x32_bf16((a), (b), (c), 0, 0, 0)
__device__ __forceinline__ bf16x8 pack8(const f32x4 a, const f32x4 b) {
    v4u w; w.x = pk2(a[0], a[1]); w.y = pk2(a[2], a[3]); w.z = pk2(b[0], b[1]); w.w = pk2(b[2], b[3]); return __builtin_bit_cast(bf16x8, w);
}
__device__ __forceinline__ bf16x8 join8(const u32x2 lo, const u32x2 hi) { v4u w; w.x = lo.x; w.y = lo.y; w.z = hi.x; w.w = hi.y; return __builtin_bit_cast(bf16x8, w); }

__device__ __forceinline__ void attn_prompt_unit(const Ctx& F, int u) {
    LAS unsigned char* L = F.lds;
    const int tid = F.tid, lane = F.lane, w = F.wave;
    const int bh = u / 96, rem = u - bh * 96, di = rem >> 5, x = rem & 31;
    const int b = bh >> 3, h = bh & 7, dsh = 2 * di, nbsh = 5 - dsh;
    const int r = x >> nbsh, qb = x & ((1 << nbsh) - 1);
    constexpr int KS_STRIDE = 144, VT_OFF = 256 * 144, VT_STRIDE = 528;
    {
        const int key = tid >> 1, half = tid & 1, isub = 128 * (qb - 1) + key;
        v4u kv[4], vv[4];
        if (isub >= 0) {
            const size_t row = (size_t)b * SEQ + r + ((size_t)isub << dsh);
            const v4u* kp = (const v4u*)(F.Kb() + row * 512 + h * 64 + 32 * half);
            const v4u* vp = (const v4u*)(F.Vb() + row * 512 + h * 64 + 32 * half);
#pragma unroll
            for (int i = 0; i < 4; ++i) { kv[i] = kp[i]; vv[i] = vp[i]; }
        } else {
#pragma unroll
            for (int i = 0; i < 4; ++i) { kv[i] = (v4u){0u, 0u, 0u, 0u}; vv[i] = (v4u){0u, 0u, 0u, 0u}; }
        }
#pragma unroll
        for (int i = 0; i < 4; ++i) *(LAS v4u*)(L + key * KS_STRIDE + (32 * half + 8 * i) * 2) = kv[i];
#pragma unroll
        for (int i = 0; i < 4; ++i)
#pragma unroll
            for (int c = 0; c < 4; ++c) { const unsigned wd = vv[i][c]; const int e = 32 * half + 8 * i + 2 * c;
                *(LAS u16*)(L + VT_OFF + e * VT_STRIDE + key * 2) = (u16)(wd & 0xffffu);
                *(LAS u16*)(L + VT_OFF + (e + 1) * VT_STRIDE + key * 2) = (u16)(wd >> 16); }
    }
    __syncthreads();
    const int q = lane & 15, g = lane >> 4;
    const int iq = 128 * qb + 16 * w + q;
    const size_t qrow = (size_t)b * SEQ + r + ((size_t)iq << dsh);
    const bf16x8 qf0 = *(const bf16x8*)(F.Qb() + qrow * 512 + h * 64 + 8 * g), qf1 = *(const bf16x8*)(F.Qb() + qrow * 512 + h * 64 + 32 + 8 * g);
    f32x4 s[9];
#pragma unroll
    for (int kt = 0; kt < 9; ++kt) {
        const int key = 16 * (w + kt) + q;
        const bf16x8 a0 = *(const LAS bf16x8*)(L + key * KS_STRIDE + (8 * g) * 2), a1 = *(const LAS bf16x8*)(L + key * KS_STRIDE + (32 + 8 * g) * 2);
        f32x4 acc = (f32x4){0.f, 0.f, 0.f, 0.f};
        acc = MFMA16(a0, qf0, acc); acc = MFMA16(a1, qf1, acc); s[kt] = acc;
    }
    float mx = -INFINITY;
#pragma unroll
    for (int kt = 0; kt < 9; ++kt)
#pragma unroll
        for (int rg = 0; rg < 4; ++rg) { const int cc = 16 * kt + 4 * g + rg; const bool ok = (cc >= q) && (cc <= q + 128) && (qb > 0 || 16 * w + cc >= 128);
            const float v = ok ? s[kt][rg] * 0.125f : -INFINITY; s[kt][rg] = v; mx = fmaxf(mx, v); }
    mx = fmaxf(mx, __shfl_xor(mx, 16)); mx = fmaxf(mx, __shfl_xor(mx, 32));
    float lsum = 0.f;
#pragma unroll
    for (int kt = 0; kt < 9; ++kt)
#pragma unroll
        for (int rg = 0; rg < 4; ++rg) { const float p = __expf(s[kt][rg] - mx); s[kt][rg] = p; lsum += p; }
    lsum += __shfl_xor(lsum, 16); lsum += __shfl_xor(lsum, 32);
    f32x4 o[4];
#pragma unroll
    for (int et = 0; et < 4; ++et) o[et] = (f32x4){0.f, 0.f, 0.f, 0.f};
    const f32x4 zero4 = (f32x4){0.f, 0.f, 0.f, 0.f};
#pragma unroll
    for (int p = 0; p < 5; ++p) {
        const bf16x8 pa = pack8(s[2 * p], p < 4 ? s[2 * p + 1] : zero4);
#pragma unroll
        for (int et = 0; et < 4; ++et) {
            const LAS unsigned char* vb = L + VT_OFF + (16 * et + q) * VT_STRIDE + (16 * w + 32 * p + 4 * g) * 2;
            const u32x2 lo = *(const LAS u32x2*)vb; u32x2 hi = (u32x2){0u, 0u}; if (p < 4) hi = *(const LAS u32x2*)(vb + 32);
            o[et] = MFMA16(pa, join8(lo, hi), o[et]);
        }
    }
#pragma unroll
    for (int rg = 0; rg < 4; ++rg) {
        const float lq = __shfl(lsum, 4 * g + rg), mq = __shfl(mx, 4 * g + rg);
        const int iq2 = 128 * qb + 16 * w + 4 * g + rg;
        const size_t row = (size_t)b * SEQ + r + ((size_t)iq2 << dsh);
        const float inv = 1.0f / lq;
        float* op = F.Opart() + ((size_t)di * MP + row) * 512 + h * 64 + q;
#pragma unroll
        for (int et = 0; et < 4; ++et) op[16 * et] = o[et][rg] * inv;
        if (q == 0) F.Lse()[((size_t)di * MP + row) * 8 + h] = mq + __logf(lq);
    }
    __syncthreads();
}
__device__ __forceinline__ void attn_combine_rows(const Ctx& F) {
    const int gw = F.bid * NWAVES + F.wave, NGW = F.G * NWAVES, lane = F.lane, h = lane >> 3;
    for (int m = gw; m < MP; m += NGW) {
        float ls[3], wt[3];
#pragma unroll
        for (int i = 0; i < 3; ++i) ls[i] = F.Lse()[((size_t)i * MP + m) * 8 + h];
        const float mxl = fmaxf(ls[0], fmaxf(ls[1], ls[2])); float den = 0.f;
#pragma unroll
        for (int i = 0; i < 3; ++i) { wt[i] = __expf(ls[i] - mxl); den += wt[i]; }
        const float rden = 1.0f / den;
        f32x4 a0 = (f32x4){0.f, 0.f, 0.f, 0.f}, a1 = a0;
#pragma unroll
        for (int i = 0; i < 3; ++i) { const f32x4* p = (const f32x4*)(F.Opart() + ((size_t)i * MP + m) * 512 + lane * 8); a0 += p[0] * (wt[i] * rden); a1 += p[1] * (wt[i] * rden); }
        v4u o; o.x = pk2(a0[0], a0[1]); o.y = pk2(a0[2], a0[3]); o.z = pk2(a1[0], a1[1]); o.w = pk2(a1[2], a1[3]);
        *(v4u*)(F.Cat() + (size_t)m * 1024 + lane * 8) = o;
    }
}
__device__ __forceinline__ const float* samp_row(const float* cache, const float* onew, int bd, int idx, int h) {
    return idx < 2048 ? cache + ((size_t)(bd * 2048 + idx) * 512 + h * 64) : onew + ((size_t)(bd * 2048 + 2044 + (idx - 2048)) * 512 + h * 64);
}
__device__ __forceinline__ void attn_sample_unit(const Ctx& F, int u) {
    const int bd = u >> 3, h = u & 7, tid = F.tid, lane = F.lane, w = F.wave;
    LAS float* sc = (LAS float*)F.lds;
    LAS float* stt = (LAS float*)(F.lds + 6400);
    LAS float* red = (LAS float*)(F.lds + 8192);
    const int grp = tid >> 4, li = tid & 15;
    const float* okn = F.out + O_KS; const float* ovn = F.out + O_VS;
#pragma unroll 1
    for (int s = 0; s < 4; ++s) {
        const u32x2 qw = *(const u32x2*)(F.Qb() + (size_t)(MP + bd * 4 + s) * 512 + h * 64 + 4 * li);
        const f32x4 qv = (f32x4){bf2f(qw.x & 0xffffu), bf2f(qw.x >> 16), bf2f(qw.y & 0xffffu), bf2f(qw.y >> 16)} * 0.125f;
#pragma unroll
        for (int n = 0; n < 13; ++n) {
            const int it = grp + 32 * n;
            if (it < 387) {
                const int di = it / 129, j = it - di * 129, idx = 2048 + s - (j << (2 * di));
                const f32x4 kk = *(const f32x4*)(samp_row(F.ck, okn, bd, idx, h) + 4 * li);
                float dot = (qv[0] * kk[0] + qv[1] * kk[1]) + (qv[2] * kk[2] + qv[3] * kk[3]);
                dot += __shfl_xor(dot, 1); dot += __shfl_xor(dot, 2); dot += __shfl_xor(dot, 4); dot += __shfl_xor(dot, 8);
                if (li == 0) sc[(s * 3 + di) * 132 + j] = dot;
            }
        }
    }
    __syncthreads();
    for (int c = w; c < 12; c += 8) {
        const float v0 = sc[c * 132 + lane], v1 = sc[c * 132 + 64 + lane], v2 = (lane == 0) ? sc[c * 132 + 128] : -INFINITY;
        float mx = fmaxf(v0, fmaxf(v1, v2));
#pragma unroll
        for (int o = 1; o < 64; o <<= 1) mx = fmaxf(mx, __shfl_xor(mx, o));
        const float p0 = __expf(v0 - mx), p1 = __expf(v1 - mx), p2 = (lane == 0) ? __expf(v2 - mx) : 0.f;
        const float l = wave_sum(p0 + p1 + p2);
        sc[c * 132 + lane] = p0; sc[c * 132 + 64 + lane] = p1; if (lane == 0) { sc[c * 132 + 128] = p2; stt[2 * c] = mx; stt[2 * c + 1] = l; }
    }
    __syncthreads();
#pragma unroll 1
    for (int s = 0; s < 4; ++s) {
        float coef[3];
        { float ls[3], mxl = -INFINITY, den = 0.f;
#pragma unroll
          for (int i = 0; i < 3; ++i) { ls[i] = stt[2 * (s * 3 + i)] + __logf(stt[2 * (s * 3 + i) + 1]); mxl = fmaxf(mxl, ls[i]); }
#pragma unroll
          for (int i = 0; i < 3; ++i) { coef[i] = __expf(ls[i] - mxl); den += coef[i]; }
#pragma unroll
          for (int i = 0; i < 3; ++i) coef[i] = coef[i] / (den * stt[2 * (s * 3 + i) + 1]); }
        f32x4 acc = (f32x4){0.f, 0.f, 0.f, 0.f};
#pragma unroll
        for (int n = 0; n < 13; ++n) {
            const int it = grp + 32 * n;
            if (it < 387) {
                const int di = it / 129, j = it - di * 129, idx = 2048 + s - (j << (2 * di));
                const f32x4 vv = *(const f32x4*)(samp_row(F.cv, ovn, bd, idx, h) + 4 * li);
                const float p = sc[(s * 3 + di) * 132 + j] * (di == 0 ? coef[0] : (di == 1 ? coef[1] : coef[2]));
                acc += vv * p;
            }
        }
        *(LAS f32x4*)(red + (s * 32 + grp) * 64 + 4 * li) = acc;
    }
    __syncthreads();
    if (tid < 256) {
        const int s = tid >> 6, e = tid & 63; float a = 0.f;
        for (int gI = 0; gI < 32; ++gI) a += red[(s * 32 + gI) * 64 + e];
        F.Cat()[(size_t)(MP + bd * 4 + s) * 1024 + h * 64 + e] = (bf16)f2bf(a);
    }
    __syncthreads();
}
__device__ __forceinline__ void hgrn_sample_unit(const Ctx& F, int u) {
    const int bd = u >> 2, hh = u & 3, tid = F.tid, lane = F.lane, w = F.wave;
    LAS float* part = (LAS float*)F.lds;
    LAS float* ssq = (LAS float*)(F.lds + 32768);
    const int v4 = tid & 31, kq = tid >> 5;
    const float* sp = F.st0 + ((size_t)u * 128 + 8 * kq) * 128 + 4 * v4;
    float* so = F.out + O_SS + ((size_t)u * 128 + 8 * kq) * 128 + 4 * v4;
    f32x4 S[8];
#pragma unroll
    for (int i = 0; i < 8; ++i) S[i] = *(const f32x4*)(sp + (size_t)i * 128);
#pragma unroll
    for (int s = 0; s < 4; ++s) {
        const size_t base = (size_t)(MP + bd * 4 + s) * 512 + hh * 128;
        const f32x4 kh0 = *(const f32x4*)(F.KH() + base + 8 * kq), kh1 = *(const f32x4*)(F.KH() + base + 8 * kq + 4);
        const f32x4 q0 = *(const f32x4*)(F.HQ() + base + 8 * kq), q1 = *(const f32x4*)(F.HQ() + base + 8 * kq + 4);
        const f32x4 iv = *(const f32x4*)(F.HI() + base + 4 * v4);
        f32x4 po = (f32x4){0.f, 0.f, 0.f, 0.f};
#pragma unroll
        for (int i = 0; i < 8; ++i) { const float kh = i < 4 ? kh0[i & 3] : kh1[i & 3], qq = i < 4 ? q0[i & 3] : q1[i & 3];
            S[i] = S[i] * (1.0f - kh) + iv * kh; po += S[i] * qq; }
        *(LAS f32x4*)(part + (s * 16 + kq) * 128 + 4 * v4) = po;
    }
#pragma unroll
    for (int i = 0; i < 8; ++i) *(f32x4*)(so + (size_t)i * 128) = S[i];
    __syncthreads();
    const int s = tid >> 7, v = tid & 127; float o = 0.f;
#pragma unroll
    for (int k2 = 0; k2 < 16; ++k2) o += part[(s * 16 + k2) * 128 + v];
    const float sq = wave_sum(o * o);
    if (lane == 0) ssq[w] = sq;
    __syncthreads();
    const float tot = ssq[2 * s] + ssq[2 * s + 1];
    const float rstd = 1.0f / sqrtf(tot * (1.0f / 128.0f) + LN_EPS);
    const size_t row = (size_t)(MP + bd * 4 + s); const int col = hh * 128 + v;
    F.Cat()[row * 1024 + 512 + col] = (bf16)f2bf(o * rstd * F.hng[col] * F.HG()[row * 512 + col]);
    __syncthreads();
}
constexpr int HG_QD = 0, HG_KD = 8704, HG_KET = 17408, HG_VT = 27648, HG_DEC = 37888, HG_QT = 38400, HG_SSQ = 40448;
template <bool FULL>
__device__ __forceinline__ float hgrn_prep(const Ctx& F, int b, int hh, int t0) {
    LAS unsigned char* L = F.lds; const int tid = F.tid, k = tid & 127, tq = tid >> 7;
    const size_t rbase = ((size_t)b * SEQ + t0 + 8 * tq) * 512 + hh * 128 + k;
    float cum[8];
#pragma unroll
    for (int i = 0; i < 8; ++i) cum[i] = F.LOGF()[rbase + (size_t)i * 512];
#pragma unroll
    for (int i = 1; i < 8; ++i) cum[i] += cum[i - 1];
    LAS float* QT = (LAS float*)(L + HG_QT);
    QT[tq * 128 + k] = cum[7];
    __syncthreads();
    float off = 0.f, tot = 0.f;
#pragma unroll
    for (int q2 = 0; q2 < 4; ++q2) { const float v = QT[q2 * 128 + k]; off += (q2 < tq) ? v : 0.f; tot += v; }
#pragma unroll
    for (int i = 0; i < 8; ++i) {
        const float c = cum[i] + off; const int t = 8 * tq + i;
        const float kh = F.KH()[rbase + (size_t)i * 512];
        if (FULL) { const float qv = F.HQ()[rbase + (size_t)i * 512];
            *(LAS u16*)(L + HG_QD + t * 272 + k * 2) = (u16)f2bf(qv * __expf(c));
            *(LAS u16*)(L + HG_KD + t * 272 + k * 2) = (u16)f2bf(kh * __expf(-c)); }
        *(LAS u16*)(L + HG_KET + k * 80 + t * 2) = (u16)f2bf(kh * __expf(tot - c));
        *(LAS u16*)(L + HG_VT + k * 80 + t * 2) = (u16)f2bf(F.HI()[rbase + (size_t)i * 512]);
    }
    if (tq == 0) *(LAS float*)(L + HG_DEC + k * 4) = __expf(tot);
    __syncthreads();
    return tot;
}
__device__ __forceinline__ void hgrn_update(const Ctx& F, f32x4 (&S)[8]) {
    LAS unsigned char* L = F.lds; const int c16 = F.lane & 15, g = F.lane >> 4, w = F.wave;
    const bf16x8 vB = *(const LAS bf16x8*)(L + HG_VT + (16 * w + c16) * 80 + (8 * g) * 2);
#pragma unroll
    for (int a = 0; a < 8; ++a) {
        const f32x4 dc = *(const LAS f32x4*)(L + HG_DEC + (16 * a + 4 * g) * 4);
        const bf16x8 keA = *(const LAS bf16x8*)(L + HG_KET + (16 * a + c16) * 80 + (8 * g) * 2);
        S[a] = MFMA16(keA, vB, S[a] * dc);
    }
}
__device__ __forceinline__ void hgrn_pass1_unit(const Ctx& F, int u) {
    const int bh = u >> 4, seg = u & 15, b = bh >> 2, hh = bh & 3;
    f32x4 S[8];
#pragma unroll
    for (int a = 0; a < 8; ++a) S[a] = (f32x4){0.f, 0.f, 0.f, 0.f};
    float dsum = 0.f;
    for (int c = 0; c < 8; ++c) { dsum += hgrn_prep<false>(F, b, hh, seg * 256 + c * 32); hgrn_update(F, S); __syncthreads(); }
    if (F.tid < 128) F.Dseg()[(size_t)u * 128 + F.tid] = __expf(dsum);
#pragma unroll
    for (int a = 0; a < 8; ++a) *(f32x4*)(F.Useg() + ((((size_t)u * 8 + F.wave) * 8 + a) * 64 + F.lane) * 4) = S[a];
}
__device__ __forceinline__ void hgrn_pass2_unit(const Ctx& F, int u) {
    LAS unsigned char* L = F.lds;
    const int bh = u >> 4, seg = u & 15, b = bh >> 2, hh = bh & 3, lane = F.lane, w = F.wave, c16 = lane & 15, g = lane >> 4;
    f32x4 S[8];
#pragma unroll
    for (int a = 0; a < 8; ++a) S[a] = (f32x4){0.f, 0.f, 0.f, 0.f};
    for (int sp = 0; sp < seg; ++sp) { const size_t pu = (size_t)bh * 16 + sp;
#pragma unroll
        for (int a = 0; a < 8; ++a) { const f32x4 dc = *(const f32x4*)(F.Dseg() + pu * 128 + 16 * a + 4 * g); const f32x4 U = *(const f32x4*)(F.Useg() + (((pu * 8 + w) * 8 + a) * 64 + lane) * 4); S[a] = S[a] * dc + U; } }
    for (int c = 0; c < 8; ++c) {
        const int t0 = seg * 256 + c * 32;
        (void)hgrn_prep<true>(F, b, hh, t0);
        f32x4 am[2][2];
#pragma unroll
        for (int jt = 0; jt < 2; ++jt)
#pragma unroll
            for (int it = 0; it < 2; ++it) am[jt][it] = (f32x4){0.f, 0.f, 0.f, 0.f};
#pragma unroll
        for (int s4 = 0; s4 < 4; ++s4) {
            bf16x8 kdA[2], qdB[2];
#pragma unroll
            for (int t2 = 0; t2 < 2; ++t2) { kdA[t2] = *(const LAS bf16x8*)(L + HG_KD + (16 * t2 + c16) * 272 + (32 * s4 + 8 * g) * 2); qdB[t2] = *(const LAS bf16x8*)(L + HG_QD + (16 * t2 + c16) * 272 + (32 * s4 + 8 * g) * 2); }
#pragma unroll
            for (int jt = 0; jt < 2; ++jt)
#pragma unroll
                for (int it = 0; it < 2; ++it) am[jt][it] = MFMA16(kdA[jt], qdB[it], am[jt][it]);
        }
#pragma unroll
        for (int jt = 0; jt < 2; ++jt)
#pragma unroll
            for (int it = 0; it < 2; ++it)
#pragma unroll
                for (int rg = 0; rg < 4; ++rg) if (16 * jt + 4 * g + rg > 16 * it + c16) am[jt][it][rg] = 0.f;
        f32x4 o[2];
        { const LAS unsigned char* vb = L + HG_VT + (16 * w + c16) * 80 + (4 * g) * 2;
          const bf16x8 vB = join8(*(const LAS u32x2*)vb, *(const LAS u32x2*)(vb + 32));
#pragma unroll
          for (int it = 0; it < 2; ++it) o[it] = MFMA16(pack8(am[0][it], am[1][it]), vB, ((f32x4){0.f, 0.f, 0.f, 0.f})); }
#pragma unroll
        for (int kp = 0; kp < 4; ++kp) {
            const bf16x8 sB = pack8(S[2 * kp], S[2 * kp + 1]);
#pragma unroll
            for (int it = 0; it < 2; ++it) { const LAS unsigned char* qp = L + HG_QD + (16 * it + c16) * 272 + (32 * kp + 4 * g) * 2;
                o[it] = MFMA16(join8(*(const LAS u32x2*)qp, *(const LAS u32x2*)(qp + 32)), sB, o[it]); }
        }
        hgrn_update(F, S);
        LAS float* SSQ = (LAS float*)(L + HG_SSQ);
#pragma unroll
        for (int it = 0; it < 2; ++it)
#pragma unroll
            for (int rg = 0; rg < 4; ++rg) { float sq = o[it][rg] * o[it][rg]; sq += __shfl_xor(sq, 1); sq += __shfl_xor(sq, 2); sq += __shfl_xor(sq, 4); sq += __shfl_xor(sq, 8);
                if (c16 == 0) SSQ[w * 32 + 16 * it + 4 * g + rg] = sq; }
        __syncthreads();
        const int col = hh * 128 + 16 * w + c16; const float ng = F.hng[col];
#pragma unroll
        for (int it = 0; it < 2; ++it)
#pragma unroll
            for (int rg = 0; rg < 4; ++rg) { const int i = 16 * it + 4 * g + rg; float tot = 0.f;
#pragma unroll
                for (int w2 = 0; w2 < 8; ++w2) tot += SSQ[w2 * 32 + i];
                const float rstd = 1.0f / sqrtf(tot * (1.0f / 128.0f) + LN_EPS);
                const size_t row = (size_t)b * SEQ + t0 + i;
                F.Cat()[row * 1024 + 512 + col] = (bf16)f2bf(o[it][rg] * rstd * ng * F.HG()[row * 512 + col]); }
        __syncthreads();
    }
    if (seg == 15) {
#pragma unroll
        for (int a = 0; a < 8; ++a)
#pragma unroll
            for (int rg = 0; rg < 4; ++rg) F.out[O_SP + ((size_t)bh * 128 + 16 * a + 4 * g + rg) * 128 + 16 * w + c16] = S[a][rg];
    }
}
struct Args { const float* in[21]; float* out; unsigned char* ws; };
__global__ void __launch_bounds__(NWAVES * 64, 2) fwd_kernel(Args args) {
    extern __shared__ __attribute__((aligned(16))) unsigned char lds[];
    Ctx F;
    F.lds = (LAS unsigned char*)lds;
    const int wave_s = __builtin_amdgcn_readfirstlane((int)threadIdx.x >> 6);
    F.tid = threadIdx.x; F.lane = F.tid & 63; F.wave = wave_s; F.G = gridDim.x; F.bid = blockIdx.x;
    F.xp = args.in[0]; F.xs = args.in[1]; F.ck = args.in[2]; F.cv = args.in[3]; F.st0 = args.in[4]; F.w1g = args.in[5]; F.w1u = args.in[6]; F.w1d = args.in[7]; F.ln1g = args.in[8]; F.ln1b = args.in[9];
    F.win = args.in[10]; F.hlb = args.in[11]; F.hng = args.in[12]; F.wout = args.in[13]; F.ln2g = args.in[14]; F.ln2b = args.in[15]; F.w2g = args.in[16]; F.w2u = args.in[17]; F.w2d = args.in[18]; F.ln3g = args.in[19]; F.ln3b = args.in[20];
    F.out = args.out; F.ws = args.ws; unsigned char* ws = args.ws;


    for (int u = F.tid; u < (LDS_BYTES - LDSCTL_OFF) / 4; u += NWAVES * 64) ((LAS unsigned*)(F.lds + LDSCTL_OFF))[u] = 0u;
    __syncthreads();
    XcdBarrier bar = xcd_barrier_post((unsigned*)(ws + WS_CTL) + CW_BAR, (volatile LAS unsigned*)(F.lds + MISC_OFF) + 8);
#define REFRESH() do { int l_ = (int)__builtin_amdgcn_mbcnt_hi(~0u, __builtin_amdgcn_mbcnt_lo(~0u, 0u)); asm volatile("" : "+v"(l_)); F.lane = l_; F.wave = wave_s; F.tid = wave_s * 64 + l_; } while (0)
#define GRID_BAR() do { xcd_barrier(bar); REFRESH(); } while (0)

#if PHMASK & 1
    p0_prologue(F);
#endif
    GRID_BAR();
#if PHMASK & 2
    { pg8::Gemm g{F.Xb(), F.W1gu(), M, NGU, D}; pg8::StaticOrder S; S.init(M, NGU, F.G, F.bid); pg8::EpiSwiGLU E{F.Hb(), FF};
      pg8::gemm_phase<pg8::EpiSwiGLU, pg8::StaticOrder, true, true>(F.lds + RING_OFF, g, S, E, F.tid); }
#endif
    GRID_BAR();
#if PHMASK & 4
    { pg8::Gemm g{F.Hb(), F.W1d(), M, D, FF}; pg8::StaticOrder S; S.init(M, D, F.G, F.bid); pg8::EpiResid E{F.xp, F.xs, F.Ypre(), DN_ALPHA, 0.5f};
      pg8::gemm_phase<pg8::EpiResid, pg8::StaticOrder, true, true>(F.lds + RING_OFF, g, S, E, F.tid); }
#endif
    GRID_BAR();
#if PHMASK & 8
    ln_rows(F, F.Ypre(), F.ln1g, F.ln1b, F.X1(), F.X1b());
#endif
    GRID_BAR();
#if PHMASK & 16
    { pg8::Gemm g{F.X1b(), F.Win(), M, NIN, D}; pg8::StaticOrder S; S.init(M, NIN, F.G, F.bid);
      pg8::EpiWin E{F.Qb(), F.Kb(), F.Vb(), F.HQ(), F.LOGF(), F.KH(), F.HI(), F.HG(), F.COS(), F.SIN(), F.LB(), F.out + O_KP, F.out + O_VP, F.out + O_KS, F.out + O_VS};
      pg8::gemm_phase<pg8::EpiWin, pg8::StaticOrder, true, true>(F.lds + RING_OFF, g, S, E, F.tid); }
#endif
    GRID_BAR();
#if PHMASK & 32
    for (int u = F.bid; u < 256; u += F.G) hgrn_pass1_unit(F, u);
#endif
#if PHMASK & 64
    for (int u = F.bid; u < 3072; u += F.G) attn_prompt_unit(F, u);
#endif
#if PHMASK & 128
    for (int u = F.bid; u < 1024; u += F.G) attn_sample_unit(F, u);
#endif
#if PHMASK & 256
    for (int u = F.bid; u < 512; u += F.G) hgrn_sample_unit(F, u);
#endif
    GRID_BAR();
#if PHMASK & 512
    for (int u = F.bid; u < 256; u += F.G) hgrn_pass2_unit(F, u);
#endif
#if PHMASK & 1024
    attn_combine_rows(F);
#endif
    GRID_BAR();
#if PHMASK & 2048
    { pg8::Gemm g{F.Cat(), F.Wout(), M, D, D}; pg8::StaticOrder S; S.init(M, D, F.G, F.bid); pg8::EpiResid E{F.X1(), F.X1() + (size_t)MP * D, F.Ypre(), DN_ALPHA, 1.0f};
      pg8::gemm_phase<pg8::EpiResid, pg8::StaticOrder, true, true>(F.lds + RING_OFF, g, S, E, F.tid); }
#endif
    GRID_BAR();
    ln_rows(F, F.Ypre(), F.ln2g, F.ln2b, F.X2(), F.X2b());
    GRID_BAR();
    { pg8::Gemm g{F.X2b(), F.W2gu(), M, NGU, D}; pg8::StaticOrder S; S.init(M, NGU, F.G, F.bid); pg8::EpiSwiGLU E{F.Hb(), FF};
      pg8::gemm_phase<pg8::EpiSwiGLU, pg8::StaticOrder, true, true>(F.lds + RING_OFF, g, S, E, F.tid); }
    GRID_BAR();
    { pg8::Gemm g{F.Hb(), F.W2d(), M, D, FF}; pg8::StaticOrder S; S.init(M, D, F.G, F.bid); pg8::EpiResid E{F.X2(), F.X2() + (size_t)MP * D, F.Ypre(), DN_ALPHA, 0.5f};
      pg8::gemm_phase<pg8::EpiResid, pg8::StaticOrder, true, true>(F.lds + RING_OFF, g, S, E, F.tid); }
    GRID_BAR();
    ln_rows(F, F.Ypre(), F.ln3g, F.ln3b, F.out + O_YP, (bf16*)nullptr);
}
#if DBG
constexpr int DBG_NST = 14, DBG_NS = 6;
__device__ __forceinline__ unsigned dhash(unsigned x) { x ^= x >> 16; x *= 0x7feb352dU; x ^= x >> 15; x *= 0x846ca68bU; x ^= x >> 16; return x; }
__device__ __forceinline__ float dbf(bf16 h) { return bf2f((unsigned)h); }
__device__ __forceinline__ float rbf(float x) { return bf2f(f2bf(x)); }
__device__ __forceinline__ float dsig(float x) { return 1.0f / (1.0f + __expf(-x)); }
__device__ __forceinline__ void dmax(unsigned* slot, float e) { unsigned b = (e != e) ? 0x7fc00000u : __builtin_bit_cast(unsigned, fabsf(e)); atomicMax(slot, b); }
__device__ __forceinline__ float block_sum1024(float v, float* sh) {
    v = wave_sum(v); __syncthreads(); if ((threadIdx.x & 63) == 0) sh[threadIdx.x >> 6] = v; __syncthreads(); float t = 0.f; for (int i = 0; i < 16; ++i) t += sh[i]; __syncthreads(); return t;
}
__device__ void dbg_ffn_row(const float* res, const bf16* xb, const bf16* Wgu, const bf16* Wd, const float* lg, const float* lb, const float* got, unsigned* slot, float* hs, float* ys, float* sh) {
    const int tid = threadIdx.x;
    for (int hc = tid; hc < FF; hc += 1024) {
        const bf16* wg = Wgu + (size_t)(256 * (hc >> 7) + (hc & 127)) * D; const bf16* wu = wg + (size_t)128 * D; float g = 0.f, u = 0.f;
        for (int k = 0; k < D; ++k) { const float x = dbf(xb[k]); g += x * dbf(wg[k]); u += x * dbf(wu[k]); }
        hs[hc] = rbf(g * dsig(g) * u);
    }
    __syncthreads();
    float acc = 0.f; { const bf16* wd = Wd + (size_t)tid * FF; for (int j = 0; j < FF; ++j) acc += hs[j] * dbf(wd[j]); }
    const float y = DN_ALPHA * res[tid] + 0.5f * acc;
    const float mean = block_sum1024(y, sh) * (1.f / D); const float var = block_sum1024((y - mean) * (y - mean), sh) * (1.f / D);
    const float want = (y - mean) / sqrtf(var + LN_EPS) * lg[tid] + lb[tid];
    dmax(slot, (got[tid] - want)); (void)ys;
}
__global__ void __launch_bounds__(1024, 1) dbg_check(Args args) {
    __shared__ float hs[FF]; __shared__ float ys[1024]; __shared__ float sh[64]; __shared__ float ov[128];
    Ctx F; unsigned char* ws = args.ws;
    F.xp = args.in[0]; F.xs = args.in[1]; F.ck = args.in[2]; F.cv = args.in[3]; F.st0 = args.in[4]; F.w1g = args.in[5]; F.w1u = args.in[6]; F.w1d = args.in[7]; F.ln1g = args.in[8]; F.ln1b = args.in[9];
    F.win = args.in[10]; F.hlb = args.in[11]; F.hng = args.in[12]; F.wout = args.in[13]; F.ln2g = args.in[14]; F.ln2b = args.in[15]; F.w2g = args.in[16]; F.w2u = args.in[17]; F.w2d = args.in[18]; F.ln3g = args.in[19]; F.ln3b = args.in[20];
    F.out = args.out; F.ws = ws;


    unsigned* DB = (unsigned*)(ws + WS_DBG);
    const int stage = blockIdx.x / DBG_NS, smp = blockIdx.x % DBG_NS, tid = threadIdx.x;
    unsigned* slot = DB + stage;
    const unsigned hb = dhash(blockIdx.x * 7919u + 13u), ht = dhash(hb + tid * 2654435761u);
    if (stage == 0) {
        { const int c = ht % FF, k = dhash(ht + 1) % D; dmax(slot, dbf(F.W1gu()[(size_t)(256 * (c >> 7) + (c & 127)) * D + k]) - rbf(F.w1g[(size_t)k * FF + c])); dmax(slot, dbf(F.W1gu()[(size_t)(256 * (c >> 7) + 128 + (c & 127)) * D + k]) - rbf(F.w1u[(size_t)k * FF + c]));
          dmax(slot, dbf(F.W2gu()[(size_t)(256 * (c >> 7) + (c & 127)) * D + k]) - rbf(F.w2g[(size_t)k * FF + c])); dmax(slot, dbf(F.W2gu()[(size_t)(256 * (c >> 7) + 128 + (c & 127)) * D + k]) - rbf(F.w2u[(size_t)k * FF + c])); }
        { const int c = ht % D, k = dhash(ht + 2) % FF; dmax(slot, dbf(F.W1d()[(size_t)c * FF + k]) - rbf(F.w1d[(size_t)k * D + c])); dmax(slot, dbf(F.W2d()[(size_t)c * FF + k]) - rbf(F.w2d[(size_t)k * D + c])); }
        { const int c = ht % NIN, k = dhash(ht + 3) % D; dmax(slot, dbf(F.Win()[(size_t)RmWin()(c) * D + k]) - rbf(F.win[(size_t)k * NIN + c])); }
        { const int c = ht % D, k = dhash(ht + 4) % D; dmax(slot, dbf(F.Wout()[(size_t)c * D + k]) - rbf(F.wout[(size_t)k * D + c])); }
    } else if (stage == 1) {
        const int m = ht % M, c = dhash(ht + 1) % D; const float x = m < MP ? F.xp[(size_t)m * D + c] : F.xs[(size_t)(m - MP) * D + c]; dmax(slot, dbf(F.Xb()[(size_t)m * D + c]) - rbf(x));
    } else if (stage == 2) {
        const int pi = (smp == 0 && tid < 8) ? 4092 + tid : (int)(ht % 4100), i = dhash(ht + 1) & 31; const int pos = pi < 4096 ? pi : 8192 + (pi - 4096);
        const float ang = (float)pos * INV_FREQ[i]; double r = (double)ang; r -= 6.283185307179586 * __builtin_rint(r * 0.15915494309189535);
        double sn = 0., cs = 0., term = 1.; for (int n = 0; n < 30; ++n) { if (n & 1) sn += ((n >> 1) & 1) ? -term : term; else cs += ((n >> 1) & 1) ? -term : term; term *= r / (double)(n + 1); }
        dmax(slot, F.COS()[pi * 32 + i] - (float)cs); dmax(slot, F.SIN()[pi * 32 + i] - (float)sn);
    } else if (stage == 3) {
        if (tid < 512) { const float a0 = F.hlb[tid], a1 = F.hlb[512 + tid]; dmax(slot, F.LB()[tid] - 1.0f / (1.0f + expf(a1 - a0))); }
    } else if (stage == 4) {
        const int b = ht & 127, rr = dhash(ht + 1) % 2044, c = dhash(ht + 2) & 511;
        dmax(slot, F.out[O_KS + ((size_t)b * 2048 + rr) * 512 + c] - F.ck[((size_t)b * 2048 + rr + 4) * 512 + c]); dmax(slot, F.out[O_VS + ((size_t)b * 2048 + rr) * 512 + c] - F.cv[((size_t)b * 2048 + rr + 4) * 512 + c]);
    } else if (stage == 5 || stage == 13) {
        const int m = (smp < 4) ? (int)(hb % MP) : MP + (int)(hb % MS);
        if (stage == 5) dbg_ffn_row(m < MP ? F.xp + (size_t)m * D : F.xs + (size_t)(m - MP) * D, F.Xb() + (size_t)m * D, F.W1gu(), F.W1d(), F.ln1g, F.ln1b, F.X1() + (size_t)m * D, slot, hs, ys, sh);
        else dbg_ffn_row(F.X2() + (size_t)m * D, F.X2b() + (size_t)m * D, F.W2gu(), F.W2d(), F.ln3g, F.ln3b, F.out + O_YP + (size_t)m * D, slot, hs, ys, sh);
    } else if (stage == 6) {
        const int m = (tid & 3) ? (int)(ht % MP) : ((tid & 4) ? MP + (int)(ht % MS) : (int)((ht % 4) * SEQ + 2048 + (dhash(ht + 9) % 2048))); const int col = dhash(ht + 1) % NIN;
        const int typ = col >> 9, c5 = col & 511; const bf16* xr = F.X1b() + (size_t)m * D;
        const int pi = m < MP ? (m & 4095) : 4096 + ((m - MP) & 3);
        float* fk = nullptr; if (m >= MP) fk = F.out + ((size_t)(((m - MP) >> 2) * 2048 + 2044 + ((m - MP) & 3))) * 512; else if ((m & 4095) >= 2048) fk = F.out + ((size_t)((m >> 12) * 2048 + (m & 4095) - 2048)) * 512;
        if (typ <= 1) {
            const int e = c5 & 63, e1 = e & 31, cb = col - e; float x1 = 0.f, x2 = 0.f; const bf16* w1 = F.Win() + (size_t)RmWin()(cb + e1) * D; const bf16* w2 = F.Win() + (size_t)RmWin()(cb + e1 + 32) * D;
            for (int k = 0; k < D; ++k) { const float x = dbf(xr[k]); x1 += x * dbf(w1[k]); x2 += x * dbf(w2[k]); }
            const float cs = F.COS()[pi * 32 + e1], sn = F.SIN()[pi * 32 + e1]; const float want = e < 32 ? x1 * cs - x2 * sn : x2 * cs + x1 * sn;
            const float got = dbf((typ == 0 ? F.Qb() : F.Kb())[(size_t)m * 512 + c5]); dmax(slot, (got - want) / (fabsf(want) + 0.2f));
            if (typ == 1 && fk) dmax(slot, (fk[(m >= MP ? O_KS : O_KP) + c5] - want) / (fabsf(want) + 0.2f));
        } else {
            float z = 0.f; const bf16* w1 = F.Win() + (size_t)col * D; for (int k = 0; k < D; ++k) z += dbf(xr[k]) * dbf(w1[k]);
            const size_t off = (size_t)m * 512 + c5;
            if (typ == 2) { dmax(slot, (dbf(F.Vb()[off]) - z) / (fabsf(z) + 0.1f)); if (fk) dmax(slot, (fk[(m >= MP ? O_VS : O_VP) + c5] - z) / (fabsf(z) + 0.1f)); }
            else if (typ == 3) dmax(slot, (F.HQ()[off] - z * dsig(z)) / (fabsf(z) + 0.1f));
            else if (typ == 4) { const float lb = 1.0f / (1.0f + expf(F.hlb[512 + c5] - F.hlb[c5])); const float f = lb + (1.f - lb) * dsig(z); dmax(slot, F.LOGF()[off] - logf(f)); dmax(slot, F.KH()[off] - (1.f - f)); }
            else if (typ == 5) dmax(slot, (F.HI()[off] - z) / (fabsf(z) + 0.1f));
            else dmax(slot, (F.HG()[off] - z * dsig(z)) / (fabsf(z) + 0.1f));
        }
    } else if (stage == 7 || stage == 8) {
        const int wv = tid >> 6, e = tid & 63; const unsigned hw = dhash(hb + wv * 977u);
        const int h = hw & 7; int m; if (stage == 7) { const int tsel = (wv & 3) == 0 ? (int)(dhash(hw + 1) % 140) : (int)(dhash(hw + 1) % SEQ); m = (int)(dhash(hw + 2) % 4) * SEQ + tsel; } else m = MP + (int)(dhash(hw + 1) % MS);
        const float qe = dbf(F.Qb()[(size_t)m * 512 + h * 64 + e]);
        float lse[3], ob[3];
        for (int di = 0; di < 3; ++di) {
            const int d = 1 << (2 * di); float mx = -INFINITY, l = 0.f, acc = 0.f;
            for (int j = 0; j <= 128; ++j) {
                float kv, vv;
                if (stage == 7) { const int t = (m & 4095) - d * j; if (t < 0) break; const size_t r = (size_t)(m - (m & 4095) + t) * 512 + h * 64 + e; kv = dbf(F.Kb()[r]); vv = dbf(F.Vb()[r]); }
                else { const int bd = (m - MP) >> 2, s = (m - MP) & 3, idx = 2048 + s - d * j; const size_t r = idx < 2048 ? ((size_t)(bd * 2048 + idx) * 512 + h * 64 + e) : ((size_t)(bd * 2048 + 2044 + idx - 2048) * 512 + h * 64 + e);
                       kv = idx < 2048 ? F.ck[r] : F.out[O_KS + r]; vv = idx < 2048 ? F.cv[r] : F.out[O_VS + r]; }
                const float sc = wave_sum(qe * kv) * 0.125f; const float nm = fmaxf(mx, sc); const float corr = __expf(mx - nm), p = __expf(sc - nm); l = l * corr + p; acc = acc * corr + p * vv; mx = nm;
            }
            lse[di] = mx + logf(l); ob[di] = acc / l;
        }
        const float ml = fmaxf(lse[0], fmaxf(lse[1], lse[2])); const float w0 = __expf(lse[0] - ml), w1 = __expf(lse[1] - ml), w2 = __expf(lse[2] - ml);
        const float want = (w0 * ob[0] + w1 * ob[1] + w2 * ob[2]) / (w0 + w1 + w2);
        dmax(slot, (dbf(F.Cat()[(size_t)m * 1024 + h * 64 + e]) - want) / (fabsf(want) + 0.05f));
    } else if (stage == 9 || stage == 10) {
        const int k = tid & 127, vg = tid >> 7; float S[16];
        int b = 0, hh = hb & 3, tt = 0, nstep; size_t row0;
        if (stage == 9) { b = (hb >> 2) & 3; tt = smp == 0 ? 3 : smp == 1 ? 40 : smp == 2 ? 300 : smp == 3 ? 1500 : smp == 4 ? 4095 : 2047; nstep = tt + 1; row0 = (size_t)b * SEQ;
#pragma unroll
            for (int i = 0; i < 16; ++i) S[i] = 0.f; }
        else { b = (hb >> 2) & 127; nstep = 4; tt = 3; row0 = (size_t)MP + b * 4;
#pragma unroll
            for (int i = 0; i < 16; ++i) S[i] = F.st0[((size_t)(b * 4 + hh) * 128 + k) * 128 + 16 * vg + i]; }
        for (int t = 0; t < nstep; ++t) { const size_t base = (row0 + t) * 512 + hh * 128; const float kh = F.KH()[base + k], f = __expf(F.LOGF()[base + k]);
#pragma unroll
            for (int i = 0; i < 16; ++i) S[i] = f * S[i] + kh * F.HI()[base + 16 * vg + i];
            if (t == tt || stage == 10) {
                const float q = F.HQ()[base + k];
#pragma unroll
                for (int i = 0; i < 16; ++i) { const float ps = wave_sum(q * S[i]); if ((tid & 63) == 0) sh[(tid >> 6) * 1 + 0] = ps; __syncthreads(); if (k == 0) ov[16 * vg + i] = sh[2 * vg] + sh[2 * vg + 1]; __syncthreads(); }
                float ssq = 0.f; for (int v = 0; v < 128; ++v) ssq += ov[v] * ov[v];
                const float rstd = 1.0f / sqrtf(ssq / 128.f + LN_EPS);
                if (tid < 128) { const int col = hh * 128 + tid; const float want = ov[tid] * rstd * F.hng[col] * F.HG()[(row0 + t) * 512 + col]; dmax(slot, (dbf(F.Cat()[(row0 + t) * 1024 + 512 + col]) - want) / (fabsf(want) + 0.05f)); }
                __syncthreads();
            }
        }
        if (stage == 10) { for (int i = 0; i < 16; ++i) dmax(slot, (F.out[O_SS + ((size_t)(b * 4 + hh) * 128 + k) * 128 + 16 * vg + i] - S[i]) / (fabsf(S[i]) + 0.1f)); }
        else if (tt == 4095) { for (int i = 0; i < 16; ++i) dmax(slot, (F.out[O_SP + ((size_t)(b * 4 + hh) * 128 + k) * 128 + 16 * vg + i] - S[i]) / (fabsf(S[i]) + 0.1f)); }
    } else if (stage == 11) {
        const int m = (smp < 4) ? (int)(hb % MP) : MP + (int)(hb % MS); float acc = 0.f; const bf16* cr = F.Cat() + (size_t)m * D; const bf16* wr = F.Wout() + (size_t)tid * D;
        for (int k = 0; k < D; ++k) acc += dbf(cr[k]) * dbf(wr[k]);
        const float y = DN_ALPHA * F.X1()[(size_t)m * D + tid] + acc;
        const float mean = block_sum1024(y, sh) * (1.f / D); const float var = block_sum1024((y - mean) * (y - mean), sh) * (1.f / D);
        const float want = (y - mean) / sqrtf(var + LN_EPS) * F.ln2g[tid] + F.ln2b[tid];
        dmax(slot, F.X2()[(size_t)m * D + tid] - want); dmax(slot, dbf(F.X2b()[(size_t)m * D + tid]) - rbf(F.X2()[(size_t)m * D + tid]));
    } else if (stage == 12) {
        const int m = ht % M, hc = dhash(ht + 1) % FF; const bf16* xr = F.X2b() + (size_t)m * D; const bf16* wg = F.W2gu() + (size_t)(256 * (hc >> 7) + (hc & 127)) * D; const bf16* wu = wg + (size_t)128 * D; float g = 0.f, u = 0.f;
        for (int k = 0; k < D; ++k) { const float x = dbf(xr[k]); g += x * dbf(wg[k]); u += x * dbf(wu[k]); }
        const float want = g * dsig(g) * u; dmax(slot, (dbf(F.Hb()[(size_t)m * FF + hc]) - want) / (fabsf(want) + 0.05f));
    }
}
__constant__ float DBG_TOL[DBG_NST] = {1e-6f, 1e-6f, 1e-4f, 1e-5f, 0.f, 5e-3f, 3e-2f, 4e-2f, 4e-2f, 6e-2f, 6e-2f, 5e-3f, 3e-2f, 5e-3f};
__global__ void dbg_emit(Args args) {
    if (threadIdx.x != 0) return;
    const unsigned* DB = (const unsigned*)(args.ws + WS_DBG);
    for (int s = 0; s < DBG_NST; ++s) {
        const float e = __builtin_bit_cast(float, DB[s]);
        if (!(e <= DBG_TOL[s])) {
            float mant = 9.5f; if (e == e) { float q = -10.0f * log10f(fmaxf(e, 1e-8f)); q = fminf(fmaxf(q, 0.f), 80.f); mant = 1.0f + floorf(q + 0.5f) / 10.0f; }
            float c = mant * 1e4f; for (int i = 0; i < s; ++i) c *= 10.0f;
            args.out[0] = c; return;
        }
    }
}
#define DBG_LAUNCH() do { (void)hipMemsetAsync((char*)d_ws + WS_DBG, 0, 4096, stream); hipLaunchKernelGGL(dbg_check, dim3(DBG_NST * DBG_NS), dim3(1024), 0, stream, a); hipLaunchKernelGGL(dbg_emit, dim3(1), dim3(64), 0, stream, a); } while (0)
#else
#define DBG_LAUNCH() do { } while (0)
#endif
extern "C" void kernel_launch(void* const* d_in, const int* in_sizes, int n_in, void* d_out, int out_size, void* d_ws, size_t ws_size, hipStream_t stream) {
    static int grid = 0;
    if (grid == 0) {
        if (n_in != 21 || (size_t)out_size != O_END || ws_size < WS_END) { fprintf(stderr, "kernel_launch: unexpected sizes n_in %d out %d ws %zu\n", n_in, out_size, ws_size); grid = -1; return; }
        int dev = 0, cus = 0, per_cu = 0;
        if (hipGetDevice(&dev) != hipSuccess || hipDeviceGetAttribute(&cus, hipDeviceAttributeMultiprocessorCount, dev) != hipSuccess) { grid = -1; return; }
        if (hipFuncSetAttribute((const void*)fwd_kernel, hipFuncAttributeMaxDynamicSharedMemorySize, LDS_BYTES) != hipSuccess) { fprintf(stderr, "kernel_launch: hipFuncSetAttribute failed\n"); grid = -1; return; }
        if (hipOccupancyMaxActiveBlocksPerMultiprocessor(&per_cu, (const void*)fwd_kernel, NWAVES * 64, LDS_BYTES) != hipSuccess || per_cu < 1) { fprintf(stderr, "kernel_launch: occupancy query says %d\n", per_cu); }
        (void)hipGetLastError();
        grid = cus;
    }
    if (grid < 0) return;
    if (hipMemsetAsync((char*)d_ws + WS_CTL, 0, CTL_ZERO_BYTES, stream) != hipSuccess) return;
    Args a{};
    for (int i = 0; i < 21; ++i) a.in[i] = (const float*)d_in[i];
    a.out = (float*)d_out; a.ws = (unsigned char*)d_ws;
    hipLaunchKernelGGL(fwd_kernel, dim3(grid), dim3(NWAVES * 64), LDS_BYTES, stream, a);
    DBG_LAUNCH();
}
```

```cpp
#ifndef DBG
#define DBG 0
#endif
#ifndef REPMASK
#define REPMASK 0
#endif
#ifndef PHMASK
#define PHMASK 0xFFFF
#endif
#include <hip/hip_runtime.h>
#include <cstdio>
#include <cstdint>
namespace pg8 {
#define PG8_LAS __attribute__((address_space(3)))
typedef unsigned short bf16_t;
typedef short bf16x8 __attribute__((ext_vector_type(8)));
typedef float f32x4 __attribute__((ext_vector_type(4)));
typedef unsigned u32x4 __attribute__((ext_vector_type(4)));
constexpr int BM = 256, BK = 64, HALF = 128, HTB = HALF * BK * 2  , STAGE_BYTES = 8 * HTB, NXCD = 8, WGM = 8;

__host__ __device__ __forceinline__ int lds_byte(int r, int c) { const int st = (r >> 4) * 2 + (c >> 5), rr = r & 15, cc = c & 31, ob = rr * 64 + cc * 2; return st * 1024 + (ob ^ (((ob >> 9) & 1) << 5)); }
__host__ __device__ __forceinline__ void stage_rc(int b, int& R, int& C) { const int st = b / 1024, sb = b % 1024, swz = sb ^ (((sb >> 9) & 1) << 5); R = (st >> 1) * 16 + swz / 64; C = (st & 1) * 32 + (swz % 64) / 2; }
__host__ __device__ __forceinline__ int perm32(int rho) { const int n = rho >> 4, i = rho & 15; return 8 * (i >> 2) + 4 * n + (i & 3); }

struct Unit { int pm, pn; };
struct Gemm { const bf16_t* A; const bf16_t* Bt; int M, N, K; };

struct StaticOrder {
    int nM, nN, nwg, G, c;
    __host__ __device__ void init(int M, int N, int G_, int c_) { nM = M / BM; nN = N / BM; nwg = nM * nN; G = G_; c = c_; }
    __host__ __device__ bool next(int i, Unit& u) const {
        const long L = (long)i * G + c; if (L >= nwg) return false;
        int wgid = (int)L; { const int q = nwg / NXCD, r = nwg % NXCD, xcd = wgid % NXCD, off = wgid / NXCD; wgid = (xcd < r ? xcd * (q + 1) : r * (q + 1) + (xcd - r) * q) + off; }
        const int nig = WGM * nN, gid = wgid / nig, fm = gid * WGM, gsz = (nM - fm) < WGM ? (nM - fm) : WGM;
        u.pm = fm + ((wgid % nig) % gsz); u.pn = (wgid % nig) / gsz; return true;
    }
    __device__ __forceinline__ void a_ready(const Unit&) const {}
    __device__ __forceinline__ void done(const Unit&) const {}
};

__device__ __forceinline__ void copy_piece(const f32x4* src, f32x4* dst, int n4, int tid) {
    constexpr int BT = 16, STEP = 512 * BT;
    asm volatile("" : "+v"(tid));
    f32x4 a[BT], b[BT];
#pragma unroll
    for (int j = 0; j < BT; ++j) if (tid + 512 * j < n4) a[j] = __builtin_nontemporal_load(src + tid + 512 * j);
    for (int i = tid; i < n4; i += 2 * STEP) {
#pragma unroll
        for (int j = 0; j < BT; ++j) if (i + STEP + 512 * j < n4) b[j] = __builtin_nontemporal_load(src + i + STEP + 512 * j);
#pragma unroll
        for (int j = 0; j < BT; ++j) if (i + 512 * j < n4) __builtin_nontemporal_store(a[j], dst + i + 512 * j);
#pragma unroll
        for (int j = 0; j < BT; ++j) if (i + 2 * STEP + 512 * j < n4) a[j] = __builtin_nontemporal_load(src + i + 2 * STEP + 512 * j);
#pragma unroll
        for (int j = 0; j < BT; ++j) if (i + STEP + 512 * j < n4) __builtin_nontemporal_store(b[j], dst + i + STEP + 512 * j);
    }
}
struct CopyOrder : StaticOrder {
    const f32x4* src; f32x4* dst; int n4, slot, tid; mutable int cnt;
    __device__ __forceinline__ void done(const Unit&) const { if (cnt++ == slot) copy_piece(src, dst, n4, tid); }
};

__device__ __forceinline__ unsigned cvt_pk_bf16(float lo, float hi) { unsigned r; asm volatile("v_cvt_pk_bf16_f32 %0, %1, %2" : "=v"(r) : "v"(lo), "v"(hi)); return r; }
typedef float f32x2 __attribute__((ext_vector_type(2)));
typedef unsigned u32x2 __attribute__((ext_vector_type(2)));
__device__ __forceinline__ float fsig(float x) { return __builtin_amdgcn_rcpf(1.0f + __expf(-x)); }
__device__ __forceinline__ float fsilu(float x) { return x * fsig(x); }

struct EpiSwiGLU {
    static constexpr bool PERM = true, AFTER_DRAIN = false;
    bf16_t* H; int ldh;
    __device__ __forceinline__ void operator()(const f32x4 (&acc)[2][2][4][2], const Unit& u, int wr, int wc, int fr, int fq) const {
        const int row0 = u.pm * BM + wr * 64 + fr, col0 = u.pn * HALF + wc * 32 + 8 * fq;
#pragma unroll
        for (int ai = 0; ai < 2; ++ai)
#pragma unroll
            for (int m = 0; m < 4; ++m) {
                bf16_t* p = H + (size_t)(row0 + ai * HALF + m * 16) * ldh + col0;
                const f32x4 g0 = acc[ai][0][m][0], g1 = acc[ai][0][m][1], u0 = acc[ai][1][m][0], u1 = acc[ai][1][m][1];
                float h[8];
#pragma unroll
                for (int i = 0; i < 4; ++i) { h[i] = fsilu(g0[i]) * u0[i]; h[4 + i] = fsilu(g1[i]) * u1[i]; }
                u32x4 w; w.x = cvt_pk_bf16(h[0], h[1]); w.y = cvt_pk_bf16(h[2], h[3]); w.z = cvt_pk_bf16(h[4], h[5]); w.w = cvt_pk_bf16(h[6], h[7]);
                *(u32x4*)p = w;
            }
    }
};

struct EpiResid {
    static constexpr bool PERM = false, AFTER_DRAIN = false;
    const float* resP; const float* resS; float* out; float alpha, scale;
    __device__ __forceinline__ void operator()(const f32x4 (&acc)[2][2][4][2], const Unit& u, int wr, int wc, int fr, int fq) const {
        const int row0 = u.pm * BM + wr * 64 + fr, col0 = u.pn * BM + wc * 32 + 4 * fq;
#pragma unroll
        for (int ai = 0; ai < 2; ++ai)
#pragma unroll
            for (int m = 0; m < 4; ++m) {
                const int row = row0 + ai * HALF + m * 16;
                const float* rb = (row < 16384) ? resP + (size_t)row * 1024 : resS + (size_t)(row - 16384) * 1024;
                float* ob = out + (size_t)row * 1024;
#pragma unroll
                for (int bj = 0; bj < 2; ++bj)
#pragma unroll
                    for (int n = 0; n < 2; ++n) { const int col = col0 + bj * HALF + n * 16;
                        const f32x4 r = *(const f32x4*)(rb + col); *(f32x4*)(ob + col) = r * alpha + acc[ai][bj][m][n] * scale; }
            }
    }
};

struct EpiWin {
    static constexpr bool PERM = false, AFTER_DRAIN = false;
    bf16_t *Qb, *Kb, *Vb; float *HQ, *LOGF, *KH, *HI, *HG; const float *COS, *SIN, *LB;
    float *okp, *ovp, *oks, *ovs;
    __device__ __forceinline__ float* kvdst(float* op, float* os, int row) const {
        if (row < 16384) { const int t = row & 4095, b = row >> 12; return (t >= 2048) ? op + (size_t)(b * 2048 + (t - 2048)) * 512 : (float*)nullptr; }
        const int r = row - 16384; return os + (size_t)((r >> 2) * 2048 + 2044 + (r & 3)) * 512;
    }
    __device__ __forceinline__ void operator()(const f32x4 (&acc)[2][2][4][2], const Unit& u, int wr, int wc, int fr, int fq) const {
        const int typ = u.pn >> 1, cbase = (u.pn & 1) * 256;
        const int row0 = u.pm * BM + wr * 64 + fr;
        if (typ <= 1) {
            bf16_t* dstb = typ == 0 ? Qb : Kb;
            const int e0 = 16 * (wc & 1) + 4 * fq;
#pragma unroll
            for (int ai = 0; ai < 2; ++ai)
#pragma unroll
                for (int m = 0; m < 4; ++m) {
                    const int row = row0 + ai * HALF + m * 16;
                    const int pi = (row < 16384) ? (row & 4095) : 4096 + ((row - 16384) & 3);
                    const f32x4 cs = *(const f32x4*)(COS + pi * 32 + e0), sn = *(const f32x4*)(SIN + pi * 32 + e0);
                    float* fo = (typ == 1) ? kvdst(okp, oks, row) : (float*)nullptr;
#pragma unroll
                    for (int bj = 0; bj < 2; ++bj) {
                        const int hh = (u.pn & 1) * 4 + 2 * bj + (wc >> 1);
                        const f32x4 x1 = acc[ai][bj][m][0], x2 = acc[ai][bj][m][1];
                        const f32x4 o1 = x1 * cs - x2 * sn, o2 = x2 * cs + x1 * sn;
                        bf16_t* pb = dstb + (size_t)row * 512 + hh * 64 + e0;
                        u32x2 w1, w2; w1.x = cvt_pk_bf16(o1[0], o1[1]); w1.y = cvt_pk_bf16(o1[2], o1[3]); w2.x = cvt_pk_bf16(o2[0], o2[1]); w2.y = cvt_pk_bf16(o2[2], o2[3]);
                        *(u32x2*)pb = w1; *(u32x2*)(pb + 32) = w2;
                        if (fo) { *(f32x4*)(fo + hh * 64 + e0) = o1; *(f32x4*)(fo + hh * 64 + e0 + 32) = o2; }
                    }
                }
        } else {
#pragma unroll
            for (int ai = 0; ai < 2; ++ai)
#pragma unroll
                for (int m = 0; m < 4; ++m) {
                    const int row = row0 + ai * HALF + m * 16;
                    float* fo = (typ == 2) ? kvdst(ovp, ovs, row) : (float*)nullptr;
#pragma unroll
                    for (int bj = 0; bj < 2; ++bj)
#pragma unroll
                        for (int n = 0; n < 2; ++n) {
                            const int col = cbase + bj * HALF + wc * 32 + n * 16 + 4 * fq;
                            const f32x4 z = acc[ai][bj][m][n];
                            const size_t off = (size_t)row * 512 + col;
                            if (typ == 2) {
                                u32x2 w; w.x = cvt_pk_bf16(z[0], z[1]); w.y = cvt_pk_bf16(z[2], z[3]); *(u32x2*)(Vb + off) = w;
                                if (fo) *(f32x4*)(fo + col) = z;
                            } else if (typ == 3) {
                                f32x4 o; for (int i = 0; i < 4; ++i) o[i] = fsilu(z[i]); *(f32x4*)(HQ + off) = o;
                            } else if (typ == 4) {
                                const f32x4 lb = *(const f32x4*)(LB + col); f32x4 lf, kh;
                                for (int i = 0; i < 4; ++i) { const float sg = fsig(z[i]), sm = fsig(-z[i]); lf[i] = __logf(lb[i] + (1.0f - lb[i]) * sg); kh[i] = (1.0f - lb[i]) * sm; }
                                *(f32x4*)(LOGF + off) = lf; *(f32x4*)(KH + off) = kh;
                            } else if (typ == 5) {
                                *(f32x4*)(HI + off) = z;
                            } else {
                                f32x4 o; for (int i = 0; i < 4; ++i) o[i] = fsilu(z[i]); *(f32x4*)(HG + off) = o;
                            }
                        }
                }
        }
    }
};

template <class Epi, class Sched, bool ALIGN_EPI = false, bool SP2 = false>
__device__ __forceinline__ void gemm_phase(PG8_LAS unsigned char* lds, const Gemm g, const Sched& S, const Epi& E, int tid_in) {
    int tid_o = tid_in; asm volatile("" : "+v"(tid_o));
    const int tid = tid_o, wid = __builtin_amdgcn_readfirstlane(tid >> 6), lane = tid & 63, wr = wid >> 2, wc = wid & 3, fr = lane & 15, fq = lane >> 4;
    const int K = g.K, nt = K / BK;
    unsigned voffA[2], voffB[2];
#pragma unroll
    for (int i = 0; i < 2; ++i) { int R, C; stage_rc(tid * 16 + i * 8192, R, C); const int Rb = Epi::PERM ? ((R & ~31) + perm32(R & 31)) : R;
        voffA[i] = (unsigned)(R * K + C) * 2u; voffB[i] = (unsigned)(Rb * K + C) * 2u; }
    const size_t kstep = (size_t)(BK * 2);
    const size_t hstep = (size_t)HALF * K * 2;
    const size_t tstep = 2 * hstep;
    const unsigned ldsw = (unsigned)wid * 1024u;
    const int aoff = lds_byte(wr * 64 + fr, fq * 8), boff = lds_byte(wc * 32 + fr, fq * 8);
#define PG8_SA(b, h) (((b) * 2 + (h)) * HTB)
#define PG8_SB(b, h) ((4 + (b) * 2 + (h)) * HTB)
#define PG8_STAGE(bufoff, gbase, voff) do { _Pragma("unroll") for (int _i = 0; _i < 2; ++_i) \
        __builtin_amdgcn_global_load_lds((const unsigned*)((const char*)(gbase) + (voff)[_i]), (PG8_LAS unsigned*)(lds + (bufoff) + ldsw + _i * 8192), 16, 0, 0); } while (0)
#define PG8_LDA(dst, b, h) do { _Pragma("unroll") for (int m = 0; m < 4; ++m) _Pragma("unroll") for (int k = 0; k < 2; ++k) dst[m][k] = *(const PG8_LAS bf16x8*)(lds + PG8_SA(b, h) + aoff + m * 2048 + k * 1024); } while (0)
#define PG8_LDB(dst, b, h) do { _Pragma("unroll") for (int n = 0; n < 2; ++n) _Pragma("unroll") for (int k = 0; k < 2; ++k) dst[n][k] = *(const PG8_LAS bf16x8*)(lds + PG8_SB(b, h) + boff + n * 2048 + k * 1024); } while (0)
#define PG8_MMA(ai, bj, At, Bt) do { __builtin_amdgcn_s_setprio(1); _Pragma("unroll") for (int m = 0; m < 4; ++m) _Pragma("unroll") for (int n = 0; n < 2; ++n) _Pragma("unroll") for (int k = 0; k < 2; ++k) \
        acc[ai][bj][m][n] = __builtin_amdgcn_mfma_f32_16x16x32_bf16(Bt[n][k], At[m][k], acc[ai][bj][m][n], 0, 0, 0); __builtin_amdgcn_s_setprio(0); } while (0)
#define PG8_WAIT_V(n) asm volatile("s_waitcnt vmcnt(" #n ")" ::: "memory")
#define PG8_WAIT_L(n) asm volatile("s_waitcnt lgkmcnt(" #n ")" ::: "memory")
#define PG8_BAR __builtin_amdgcn_s_barrier()
#define PG8_SCHED __builtin_amdgcn_sched_barrier(0)
    Unit cur, nxt; int ui = 0;
    if (!S.next(0, cur)) return;
    f32x4 acc[2][2][4][2];
#pragma unroll
    for (int a = 0; a < 2; ++a)
#pragma unroll
        for (int b = 0; b < 2; ++b)
#pragma unroll
            for (int m = 0; m < 4; ++m)
#pragma unroll
                for (int n = 0; n < 2; ++n) acc[a][b][m][n] = (f32x4){0.f, 0.f, 0.f, 0.f};
    bf16x8 At[4][2], B0[2][2], B1[2][2];
    const char* cA = (const char*)g.A + (size_t)cur.pm * tstep; const char* cB = (const char*)g.Bt + (size_t)cur.pn * tstep;
    S.a_ready(cur);
    if constexpr (SP2) {
        PG8_STAGE(PG8_SB(0, 0), cB, voffB); PG8_STAGE(PG8_SB(0, 1), cB + hstep, voffB); PG8_STAGE(PG8_SA(0, 0), cA, voffA); PG8_STAGE(PG8_SA(0, 1), cA + hstep, voffA);
        if (wr == 1) PG8_BAR;
        PG8_WAIT_V(2); PG8_BAR;
        PG8_STAGE(PG8_SB(1, 0), cB + kstep, voffB); PG8_STAGE(PG8_SA(1, 0), cA + kstep, voffA); PG8_STAGE(PG8_SB(1, 1), cB + hstep + kstep, voffB);
        PG8_WAIT_V(6); PG8_BAR;
    } else {
        PG8_STAGE(PG8_SB(0, 0), cB, voffB); PG8_STAGE(PG8_SA(0, 0), cA, voffA); PG8_STAGE(PG8_SB(0, 1), cB + hstep, voffB); PG8_STAGE(PG8_SA(0, 1), cA + hstep, voffA);
        if (wr == 1) PG8_BAR;
        PG8_WAIT_V(4); PG8_BAR;
        PG8_STAGE(PG8_SB(1, 0), cB + kstep, voffB); PG8_STAGE(PG8_SA(1, 0), cA + kstep, voffA); PG8_STAGE(PG8_SB(1, 1), cB + hstep + kstep, voffB);
        PG8_WAIT_V(6); PG8_BAR;
    }
    for (;;) {
        const bool has_next = S.next(ui + 1, nxt);
        const char* nA = has_next ? (const char*)g.A + (size_t)nxt.pm * tstep : cA; const char* nB = has_next ? (const char*)g.Bt + (size_t)nxt.pn * tstep : cB;
        for (int t = 0; t < nt; t += 2) {
            const bool last = (t == nt - 2);
            const char* a1 = cA + (size_t)(t + 1) * kstep;
            const char* a2 = last ? nA : cA + (size_t)(t + 2) * kstep; const char* b2 = last ? nB : cB + (size_t)(t + 2) * kstep;
            const char* a3 = a2 + kstep; const char* b3 = b2 + kstep;
            if (last && has_next) S.a_ready(nxt);
            if constexpr (SP2) {
            PG8_LDB(B0, 0, 0); PG8_LDB(B1, 0, 1); PG8_SCHED; PG8_LDA(At, 0, 0); PG8_STAGE(PG8_SA(1, 1), a1 + hstep, voffA);
            PG8_WAIT_V(8); PG8_WAIT_L(0); PG8_BAR; PG8_MMA(0, 0, At, B0); PG8_MMA(0, 1, At, B1); PG8_BAR; PG8_SCHED;
            PG8_LDA(At, 0, 1); PG8_STAGE(PG8_SB(0, 0), b2, voffB); PG8_STAGE(PG8_SB(0, 1), b2 + hstep, voffB); PG8_STAGE(PG8_SA(0, 0), a2, voffA);
            PG8_WAIT_V(8); PG8_WAIT_L(0); PG8_BAR; PG8_MMA(1, 0, At, B0); PG8_MMA(1, 1, At, B1); PG8_BAR; PG8_SCHED;
            PG8_LDB(B0, 1, 0); PG8_LDB(B1, 1, 1); PG8_SCHED; PG8_LDA(At, 1, 0); PG8_STAGE(PG8_SA(0, 1), a2 + hstep, voffA);
            PG8_WAIT_V(8); PG8_WAIT_L(0); PG8_BAR; PG8_MMA(0, 0, At, B0); PG8_MMA(0, 1, At, B1); PG8_BAR; PG8_SCHED;
            PG8_LDA(At, 1, 1); PG8_STAGE(PG8_SB(1, 0), b3, voffB); PG8_STAGE(PG8_SB(1, 1), b3 + hstep, voffB); PG8_STAGE(PG8_SA(1, 0), a3, voffA);
            PG8_WAIT_V(8); PG8_WAIT_L(0); PG8_BAR; PG8_MMA(1, 0, At, B0); PG8_MMA(1, 1, At, B1); PG8_BAR; PG8_SCHED;
            } else {
            PG8_LDB(B0, 0, 0); PG8_SCHED; PG8_LDA(At, 0, 0); PG8_STAGE(PG8_SA(1, 1), a1 + hstep, voffA);
            PG8_WAIT_L(8); PG8_BAR; PG8_WAIT_L(0); PG8_MMA(0, 0, At, B0); PG8_BAR; PG8_SCHED;
            PG8_LDB(B1, 0, 1); PG8_STAGE(PG8_SB(0, 0), b2, voffB);
            PG8_BAR; PG8_WAIT_L(0); PG8_MMA(0, 1, At, B1); PG8_BAR;
            PG8_LDA(At, 0, 1); PG8_STAGE(PG8_SA(0, 0), a2, voffA);
            PG8_BAR; PG8_WAIT_L(0); PG8_MMA(1, 0, At, B0); PG8_BAR; PG8_SCHED;
            PG8_STAGE(PG8_SB(0, 1), b2 + hstep, voffB);
            PG8_WAIT_V(6); PG8_BAR; PG8_MMA(1, 1, At, B1); PG8_BAR;
            PG8_LDB(B0, 1, 0); PG8_SCHED; PG8_LDA(At, 1, 0); PG8_STAGE(PG8_SA(0, 1), a2 + hstep, voffA);
            PG8_WAIT_L(8); PG8_BAR; PG8_WAIT_L(0); PG8_MMA(0, 0, At, B0); PG8_BAR; PG8_SCHED;
            PG8_LDB(B1, 1, 1); PG8_STAGE(PG8_SB(1, 0), b3, voffB);
            PG8_BAR; PG8_WAIT_L(0); PG8_MMA(0, 1, At, B1); PG8_BAR;
            PG8_LDA(At, 1, 1); PG8_STAGE(PG8_SA(1, 0), a3, voffA);
            PG8_BAR; PG8_WAIT_L(0); PG8_MMA(1, 0, At, B0); PG8_BAR; PG8_SCHED;
            PG8_STAGE(PG8_SB(1, 1), b3 + hstep, voffB);
            PG8_WAIT_V(6); PG8_BAR; PG8_MMA(1, 1, At, B1); PG8_BAR;
            }
        }
        if constexpr (ALIGN_EPI) { if (wr == 0) PG8_BAR; }
        if constexpr (!Epi::AFTER_DRAIN) { E(acc, cur, wr, wc, fr, fq); S.done(cur); }
        if (!has_next) break;
#pragma unroll
        for (int a = 0; a < 2; ++a)
#pragma unroll
            for (int b = 0; b < 2; ++b)
#pragma unroll
                for (int m = 0; m < 4; ++m)
#pragma unroll
                    for (int n = 0; n < 2; ++n) acc[a][b][m][n] = (f32x4){0.f, 0.f, 0.f, 0.f};
        cur = nxt; cA = nA; cB = nB; ++ui;
        if constexpr (ALIGN_EPI) { if (wr == 1) PG8_BAR; }
    }
    PG8_WAIT_V(0);
    if constexpr (!ALIGN_EPI) { if (wr == 0) PG8_BAR; }
    PG8_BAR;
    if constexpr (Epi::AFTER_DRAIN) { E.fused(acc, cur, wr, wc, fr, fq, lds, wid, lane); S.done(cur); }
#undef PG8_SA
#undef PG8_SB
#undef PG8_STAGE
#undef PG8_LDA
#undef PG8_LDB
#undef PG8_MMA
#undef PG8_WAIT_V
#undef PG8_WAIT_L
#undef PG8_BAR
#undef PG8_SCHED
}
}
#define GAS __attribute__((address_space(1)))
#define LAS __attribute__((address_space(3)))
typedef unsigned short bf16;
typedef unsigned v4u __attribute__((ext_vector_type(4)));
typedef float f32x4 __attribute__((ext_vector_type(4)));
typedef short bf16x8 __attribute__((ext_vector_type(8)));
typedef GAS unsigned gu32;
typedef GAS unsigned long long gu64;
#define RLX_AGENT __ATOMIC_RELAXED, __HIP_MEMORY_SCOPE_AGENT
#define LDS_WAIT() asm volatile("s_waitcnt lgkmcnt(0)" ::: "memory")
#define VM_WAIT() asm volatile("s_waitcnt vmcnt(0)" ::: "memory")
__device__ __forceinline__ unsigned long long rt() { return __builtin_amdgcn_s_memrealtime(); }
__device__ __forceinline__ unsigned f2bf(float f) { unsigned u = __builtin_bit_cast(unsigned, f); return (u + 0x7fffu + ((u >> 16) & 1u)) >> 16; }
__device__ __forceinline__ unsigned pk2(float lo, float hi) { return f2bf(lo) | (f2bf(hi) << 16); }

#define XB_TMO      128
#define XB_XCNT(j)  (256  + 64 * (j))
#define XB_XSUB(j)  (1280 + 64 * (j))
#define XB_XGEN(j)  (2304 + 64 * (j))
#define XB_TOP      3328
#define XB_TOPGEN   3392
#define XCD_BAR_WORDS 3456
#define XB_SPIN_CAP (1u << 18)

__device__ __forceinline__ unsigned xb_ld(unsigned* p)              { return __hip_atomic_load(p, __ATOMIC_RELAXED, __HIP_MEMORY_SCOPE_AGENT); }
__device__ __forceinline__ unsigned xb_add(unsigned* p, unsigned v) { return __hip_atomic_fetch_add(p, v, __ATOMIC_RELAXED, __HIP_MEMORY_SCOPE_AGENT); }
__device__ __forceinline__ unsigned xb_xcc_id() { return (unsigned)__builtin_amdgcn_s_getreg((3 << 11) | 20) & 0xFu; }
#define XB_SPIN(cond, bar) do { unsigned _sp = 0; while (cond) { __builtin_amdgcn_s_sleep(1); \
    if ((++_sp & 255u) == 0u) { if (xb_ld(&(bar)[XB_TMO])) break; if (_sp > XB_SPIN_CAP) { atomicAdd(&(bar)[XB_TMO], 1u); break; } } } } while (0)

struct XcdBarrier {
    unsigned* bar; unsigned x;
    volatile LAS unsigned* st;
};

__device__ __forceinline__ XcdBarrier xcd_barrier_post(unsigned* bar, volatile LAS unsigned* st) {
    XcdBarrier b; b.bar = bar; b.x = xb_xcc_id(); b.st = st;
    if (threadIdx.x == 0) (void)xb_add(&bar[XB_XCNT(b.x)], 1u);
    return b;
}
__device__ __forceinline__ void xcd_barrier_complete(unsigned* bar, unsigned x, unsigned& nloc, unsigned& nx) {
    const unsigned G = gridDim.x * gridDim.y * gridDim.z;
    unsigned sum, cnt, mine, sp = 0u;
    for (;;) {
        sum = 0u; cnt = 0u; mine = 0u;
#pragma unroll
        for (unsigned j = 0; j < 16; ++j) { const unsigned c = xb_ld(&bar[XB_XCNT(j)]); sum += c; cnt += (c > 0u) ? 1u : 0u; mine = (j == x) ? c : mine; }
        if (sum == G) break;
        __builtin_amdgcn_s_sleep(1);
        if ((++sp & 255u) == 0u) { if (xb_ld(&bar[XB_TMO])) break; if (sp > XB_SPIN_CAP) { atomicAdd(&bar[XB_TMO], 1u); break; } }
    }
    nloc = mine > 0u ? mine : 1u; nx = cnt > 0u ? cnt : 1u;
}

__device__ __forceinline__ void xcd_barrier(const XcdBarrier& b) {
    asm volatile("s_waitcnt vmcnt(0)" ::: "memory");
    __syncthreads();
    if (threadIdx.x == 0) {
        unsigned* bar = b.bar;
        __builtin_amdgcn_s_waitcnt(0);
        unsigned nloc = b.st[0], nx = b.st[1];
        if (nloc == 0u) { xcd_barrier_complete(bar, b.x, nloc, nx); b.st[0] = nloc; b.st[1] = nx; }
        const unsigned old = xb_add(&bar[XB_XSUB(b.x)], 1u);
        const unsigned gen = old / nloc;
        if (old + 1u == (gen + 1u) * nloc) {
            __builtin_amdgcn_fence(__ATOMIC_RELEASE, "agent");
            asm volatile("s_waitcnt vmcnt(0)" ::: "memory");
            const unsigned og = xb_add(&bar[XB_TOP], 1u);
            const unsigned tg = og / nx;
            if (og + 1u == (tg + 1u) * nx) xb_add(&bar[XB_TOPGEN], 1u);
            else XB_SPIN(xb_ld(&bar[XB_TOPGEN]) == tg, bar);
            __builtin_amdgcn_fence(__ATOMIC_ACQUIRE, "agent");
            xb_add(&bar[XB_XGEN(b.x)], 1u);
            asm volatile("s_waitcnt vmcnt(0)" ::: "memory");
        } else {
            XB_SPIN(xb_ld(&bar[XB_XGEN(b.x)]) == gen, bar);
            __builtin_amdgcn_fence(__ATOMIC_ACQUIRE, "agent");
            asm volatile("s_waitcnt vmcnt(0)" ::: "memory");
        }
    }
    __syncthreads();
}
constexpr int NWAVES = 8;
constexpr int D = 1024, MP = 16384, MS = 512, M = MP + MS, FF = 2816, NGU = 2 * FF, NIN = 3584, SEQ = 4096;
constexpr float LN_EPS = 1e-5f;
constexpr float DN_ALPHA = 1.189207115002721f;
constexpr size_t MiB = 1u << 20;
constexpr size_t WS_CTL = 0, CTL_ZERO_BYTES = 1 * MiB;
constexpr size_t WS_COS = 1 * MiB, WS_SIN = 1 * MiB + 640 * 1024, WS_LB = 1 * MiB + 1280 * 1024;
constexpr size_t WS_W1GU = 4 * MiB, WS_W1D = 15 * MiB, WS_WIN = 21 * MiB, WS_WOUT = 28 * MiB, WS_W2GU = 30 * MiB, WS_W2D = 41 * MiB;
constexpr size_t WS_XB = 48 * MiB, WS_X1B = 82 * MiB, WS_X2B = 116 * MiB, WS_H = 150 * MiB, WS_YPRE = 242 * MiB, WS_X1 = 308 * MiB, WS_X2 = 374 * MiB;
constexpr size_t WS_QB = 440 * MiB, WS_KB = 457 * MiB, WS_VB = 474 * MiB, WS_HQ = 491 * MiB, WS_LOGF = 524 * MiB, WS_KH = 557 * MiB, WS_HI = 590 * MiB, WS_HG = 623 * MiB;
constexpr size_t WS_CAT = 656 * MiB, WS_OPART = 689 * MiB, WS_LSE = 785 * MiB, WS_USEG = 787 * MiB, WS_DSEG = 803 * MiB, WS_DBG = 804 * MiB, WS_END = 806 * MiB;
static_assert(WS_W1GU + (size_t)NGU * D * 2 <= WS_W1D && WS_W1D + (size_t)D * FF * 2 <= WS_WIN && WS_WIN + (size_t)NIN * D * 2 <= WS_WOUT && WS_WOUT + (size_t)D * D * 2 <= WS_W2GU, "ws map (weights)");
static_assert(WS_XB + (size_t)M * D * 2 <= WS_X1B && WS_H + (size_t)M * FF * 2 <= WS_YPRE && WS_YPRE + (size_t)M * D * 4 <= WS_X1 && WS_X2 + (size_t)M * D * 4 <= WS_QB, "ws map (activations)");
static_assert(WS_QB + (size_t)M * 512 * 2 <= WS_KB && WS_HQ + (size_t)M * 512 * 4 <= WS_LOGF && WS_OPART + (size_t)3 * MP * 512 * 4 <= WS_LSE && WS_USEG + (size_t)256 * 65536 <= WS_DSEG, "ws map (mixer)");
constexpr int CW_BAR = 4096;
constexpr size_t O_YP = 0, O_YS = 16777216, O_KP = O_YS + 524288, O_VP = O_KP + 4194304, O_SP = O_VP + 4194304, O_KS = O_SP + 262144, O_VS = O_KS + 134217728, O_SS = O_VS + 134217728, O_END = O_SS + 8388608;
constexpr int RING_OFF = 0, RING_BYTES = 131072, LDSCTL_OFF = RING_BYTES, MISC_OFF = LDSCTL_OFF + 320, LDS_BYTES = 147456;

__constant__ float INV_FREQ[32] = {1.000000000e+00f, 7.498942614e-01f, 5.623413324e-01f, 4.216965139e-01f, 3.162277639e-01f, 2.371373773e-01f, 1.778279394e-01f, 1.333521307e-01f, 1.000000015e-01f, 7.498941571e-02f, 5.623413250e-02f, 4.216965288e-02f, 3.162277490e-02f, 2.371373773e-02f, 1.778279431e-02f, 1.333521493e-02f, 9.999999776e-03f, 7.498941850e-03f, 5.623413250e-03f, 4.216964822e-03f, 3.162277630e-03f, 2.371373586e-03f, 1.778279431e-03f, 1.333521446e-03f, 1.000000047e-03f, 7.498942432e-04f, 5.623413017e-04f, 4.216965172e-04f, 3.162277571e-04f, 2.371373703e-04f, 1.778279402e-04f, 1.333521504e-04f};

typedef unsigned u32x2 __attribute__((ext_vector_type(2)));
typedef unsigned short u16;
struct Ctx {
    LAS unsigned char* lds;
    int tid, lane, wave, G, bid;
    const float *xp, *xs, *ck, *cv, *st0, *w1g, *w1u, *w1d, *ln1g, *ln1b, *win, *hlb, *hng, *wout, *ln2g, *ln2b, *w2g, *w2u, *w2d, *ln3g, *ln3b;
    float* out; unsigned char* ws;
    __device__ __forceinline__ bf16* W1gu() const { return (bf16*)(ws + WS_W1GU); }
    __device__ __forceinline__ bf16* W1d() const { return (bf16*)(ws + WS_W1D); }
    __device__ __forceinline__ bf16* Win() const { return (bf16*)(ws + WS_WIN); }
    __device__ __forceinline__ bf16* Wout() const { return (bf16*)(ws + WS_WOUT); }
    __device__ __forceinline__ bf16* W2gu() const { return (bf16*)(ws + WS_W2GU); }
    __device__ __forceinline__ bf16* W2d() const { return (bf16*)(ws + WS_W2D); }
    __device__ __forceinline__ bf16* Xb() const { return (bf16*)(ws + WS_XB); }
    __device__ __forceinline__ bf16* X1b() const { return (bf16*)(ws + WS_X1B); }
    __device__ __forceinline__ bf16* X2b() const { return (bf16*)(ws + WS_X2B); }
    __device__ __forceinline__ bf16* Hb() const { return (bf16*)(ws + WS_H); }
    __device__ __forceinline__ bf16* Qb() const { return (bf16*)(ws + WS_QB); }
    __device__ __forceinline__ bf16* Kb() const { return (bf16*)(ws + WS_KB); }
    __device__ __forceinline__ bf16* Vb() const { return (bf16*)(ws + WS_VB); }
    __device__ __forceinline__ bf16* Cat() const { return (bf16*)(ws + WS_CAT); }
    __device__ __forceinline__ float* Ypre() const { return (float*)(ws + WS_YPRE); }
    __device__ __forceinline__ float* X1() const { return (float*)(ws + WS_X1); }
    __device__ __forceinline__ float* X2() const { return (float*)(ws + WS_X2); }
    __device__ __forceinline__ float* HQ() const { return (float*)(ws + WS_HQ); }
    __device__ __forceinline__ float* LOGF() const { return (float*)(ws + WS_LOGF); }
    __device__ __forceinline__ float* KH() const { return (float*)(ws + WS_KH); }
    __device__ __forceinline__ float* HI() const { return (float*)(ws + WS_HI); }
    __device__ __forceinline__ float* HG() const { return (float*)(ws + WS_HG); }
    __device__ __forceinline__ float* COS() const { return (float*)(ws + WS_COS); }
    __device__ __forceinline__ float* SIN() const { return (float*)(ws + WS_SIN); }
    __device__ __forceinline__ float* LB() const { return (float*)(ws + WS_LB); }
    __device__ __forceinline__ float* Opart() const { return (float*)(ws + WS_OPART); }
    __device__ __forceinline__ float* Lse() const { return (float*)(ws + WS_LSE); }
    __device__ __forceinline__ float* Useg() const { return (float*)(ws + WS_USEG); }
    __device__ __forceinline__ float* Dseg() const { return (float*)(ws + WS_DSEG); }
};
__device__ __forceinline__ float wave_sum(float v) {
#pragma unroll
    for (int o = 1; o < 64; o <<= 1) v += __shfl_xor(v, o);
    return v;
}
__device__ __forceinline__ float bf2f(unsigned h) { return __builtin_bit_cast(float, h << 16); }

struct RmNat { __device__ __forceinline__ int operator()(int c) const { return c; } };
struct RmGate { __device__ __forceinline__ int operator()(int c) const { return 256 * (c >> 7) + (c & 127); } };
struct RmUp { __device__ __forceinline__ int operator()(int c) const { return 256 * (c >> 7) + 128 + (c & 127); } };
struct RmWin { __device__ __forceinline__ int operator()(int c) const { if (c >= 1024) return c; const int j = c & 63; return (c & ~63) | (j & 15) | (((j >> 4) & 1) << 5) | (((j >> 5) & 1) << 4); } };
template <class RM>
__device__ __forceinline__ void p0_transpose_item(const float* W, int K, int N, bf16* WT, RM rm, LAS float* scr, int item, int lane) {
    const int nblk = N / 32, kb = item / nblk, nb = item % nblk, k0 = 64 * kb, n0 = 32 * nb;
#pragma unroll 8
    for (int i = 0; i < 32; ++i) { const int kk = 2 * i + (lane >> 5); scr[kk * 33 + (lane & 31)] = W[(size_t)(k0 + kk) * N + n0 + (lane & 31)]; }
    LDS_WAIT(); asm volatile("" ::: "memory");
    const int c = lane & 7;
#pragma unroll
    for (int j = 0; j < 4; ++j) { const int n = (lane >> 3) + 8 * j; const LAS float* s = scr + (8 * c) * 33 + n;
        v4u o; o.x = pk2(s[0 * 33], s[1 * 33]); o.y = pk2(s[2 * 33], s[3 * 33]); o.z = pk2(s[4 * 33], s[5 * 33]); o.w = pk2(s[6 * 33], s[7 * 33]);
        *(GAS v4u*)(WT + (size_t)rm(n0 + n) * K + k0 + 8 * c) = o; }
    LDS_WAIT(); asm volatile("" ::: "memory");
}
__device__ __forceinline__ void p0_prologue(const Ctx& F) {
    LAS float* scr = (LAS float*)(F.lds + RING_OFF + F.wave * 16384);
    const int gw = F.bid * NWAVES + F.wave, NGW = F.G * NWAVES;
    constexpr int I_G = (D / 64) * (FF / 32), I_D = (FF / 64) * (D / 32), I_IN = (D / 64) * (NIN / 32), I_O = (D / 64) * (D / 32);
    constexpr int NITEMS = 6 * I_G + I_IN + I_O; static_assert(I_G == I_D, "item counts");
    for (int it = gw; it < NITEMS; it += NGW) {
        int r = it;
        if (r < I_G) { p0_transpose_item(F.w1g, D, FF, F.W1gu(), RmGate(), scr, r, F.lane); continue; } r -= I_G;
        if (r < I_G) { p0_transpose_item(F.w1u, D, FF, F.W1gu(), RmUp(), scr, r, F.lane); continue; } r -= I_G;
        if (r < I_D) { p0_transpose_item(F.w1d, FF, D, F.W1d(), RmNat(), scr, r, F.lane); continue; } r -= I_D;
        if (r < I_G) { p0_transpose_item(F.w2g, D, FF, F.W2gu(), RmGate(), scr, r, F.lane); continue; } r -= I_G;
        if (r < I_G) { p0_transpose_item(F.w2u, D, FF, F.W2gu(), RmUp(), scr, r, F.lane); continue; } r -= I_G;
        if (r < I_D) { p0_transpose_item(F.w2d, FF, D, F.W2d(), RmNat(), scr, r, F.lane); continue; } r -= I_D;
        if (r < I_IN) { p0_transpose_item(F.win, D, NIN, F.Win(), RmWin(), scr, r, F.lane); continue; } r -= I_IN;
        p0_transpose_item(F.wout, D, D, F.Wout(), RmNat(), scr, r, F.lane);
    }
    for (int m = gw; m < M; m += NGW) {
        const float* xr = (m < MP) ? F.xp + (size_t)m * D : F.xs + (size_t)(m - MP) * D;
        const GAS f32x4* xv = (const GAS f32x4*)xr + F.lane; GAS unsigned long long* o8 = (GAS unsigned long long*)(F.Xb() + (size_t)m * D) + F.lane;
#pragma unroll
        for (int j = 0; j < 4; ++j) { const f32x4 v = xv[64 * j]; o8[64 * j] = (unsigned long long)pk2(v.x, v.y) | ((unsigned long long)pk2(v.z, v.w) << 32); }
    }
    for (int idx = F.bid * 512 + F.tid; idx < 4100 * 32; idx += F.G * 512) {
        const int pi = idx >> 5, i = idx & 31; const int pos = pi < 4096 ? pi : 8192 + (pi - 4096);
        const float ang = (float)pos * INV_FREQ[i];
        double rev = (double)ang * 0.15915494309189535; rev -= __builtin_rint(rev);
        const float rf = (float)rev;
        F.COS()[idx] = __builtin_amdgcn_cosf(rf); F.SIN()[idx] = __builtin_amdgcn_sinf(rf);
    }
    if (F.bid == 0) { const int c = F.tid; const float a0 = F.hlb[c], a1 = F.hlb[512 + c]; const float mx = fmaxf(a0, a1); const float e0 = __expf(a0 - mx), e1 = __expf(a1 - mx); F.LB()[c] = e0 / (e0 + e1); }
    if (F.G != 256) {
        constexpr size_t PER_B = (size_t)2044 * 512 / 4;
        const size_t nth = (size_t)F.G * 512;
        for (size_t i = (size_t)F.bid * 512 + F.tid; i < 128 * PER_B; i += nth) {
            const size_t b = i / PER_B, r = i - b * PER_B;
            const f32x4 a = __builtin_nontemporal_load((const f32x4*)(F.ck + b * 1048576 + 2048) + r);
            const f32x4 c = __builtin_nontemporal_load((const f32x4*)(F.cv + b * 1048576 + 2048) + r);
            __builtin_nontemporal_store(a, (f32x4*)(F.out + O_KS + b * 1048576) + r);
            __builtin_nontemporal_store(c, (f32x4*)(F.out + O_VS + b * 1048576) + r);
        }
    }
}
__device__ __forceinline__ void ln_rows(const Ctx& F, const float* pre, const float* gam, const float* bet, float* outf, bf16* outb) {
    const int gw = F.bid * NWAVES + F.wave, NGW = F.G * NWAVES;
    f32x4 gv[4], bv[4];
#pragma unroll
    for (int j = 0; j < 4; ++j) { gv[j] = ((const f32x4*)gam)[F.lane + 64 * j]; bv[j] = ((const f32x4*)bet)[F.lane + 64 * j]; }
    for (int m = gw; m < M; m += NGW) {
        const f32x4* xr = (const f32x4*)(pre + (size_t)m * D) + F.lane;
        f32x4 v[4]; float s = 0.f;
#pragma unroll
        for (int j = 0; j < 4; ++j) { v[j] = xr[64 * j]; s += (v[j].x + v[j].y) + (v[j].z + v[j].w); }
        const float mean = wave_sum(s) * (1.f / D); float s2 = 0.f;
#pragma unroll
        for (int j = 0; j < 4; ++j) { v[j] = v[j] - mean; s2 += (v[j].x * v[j].x + v[j].y * v[j].y) + (v[j].z * v[j].z + v[j].w * v[j].w); }
        const float rstd = 1.f / sqrtf(wave_sum(s2) * (1.f / D) + LN_EPS);
#pragma unroll
        for (int j = 0; j < 4; ++j) { const f32x4 y = v[j] * rstd * gv[j] + bv[j];
            ((f32x4*)(outf + (size_t)m * D))[F.lane + 64 * j] = y;
            if (outb) ((unsigned long long*)(outb + (size_t)m * D))[F.lane + 64 * j] = (unsigned long long)pk2(y.x, y.y) | ((unsigned long long)pk2(y.z, y.w) << 32); }
    }
}
typedef float f32x4v __attribute__((ext_vector_type(4)));
#define MFMA16(a, b, c) __builtin_amdgcn_mfma_f32_16x16x32_bf16((a), (b), (c), 0, 0, 0)
__device__ __forceinline__ bf16x8 pack8(const f32x4 a, const f32x4 b) {
    v4u w; w.x = pk2(a[0], a[1]); w.y = pk2(a[2], a[3]); w.z = pk2(b[0], b[1]); w.w = pk2(b[2], b[3]); return __builtin_bit_cast(bf16x8, w);
}
__device__ __forceinline__ bf16x8 join8(const u32x2 lo, const u32x2 hi) { v4u w; w.x = lo.x; w.y = lo.y; w.z = hi.x; w.w = hi.y; return __builtin_bit_cast(bf16x8, w); }

__device__ __forceinline__ void attn_prompt_unit(const Ctx& F, int u) {
    LAS unsigned char* L = F.lds;
    const int tid = F.tid, lane = F.lane, w = F.wave;
    const int bh = u / 96, rem = u - bh * 96, di = rem >> 5, x = rem & 31;
    const int b = bh >> 3, h = bh & 7, dsh = 2 * di, nbsh = 5 - dsh;
    const int r = x >> nbsh, qb = x & ((1 << nbsh) - 1);
    constexpr int KS_STRIDE = 144, VT_OFF = 256 * 144, VT_STRIDE = 528;
    {
        const int key = tid >> 1, half = tid & 1, isub = 128 * (qb - 1) + key;
        v4u kv[4], vv[4];
        if (isub >= 0) {
            const size_t row = (size_t)b * SEQ + r + ((size_t)isub << dsh);
            const v4u* kp = (const v4u*)(F.Kb() + row * 512 + h * 64 + 32 * half);
            const v4u* vp = (const v4u*)(F.Vb() + row * 512 + h * 64 + 32 * half);
#pragma unroll
            for (int i = 0; i < 4; ++i) { kv[i] = kp[i]; vv[i] = vp[i]; }
        } else {
#pragma unroll
            for (int i = 0; i < 4; ++i) { kv[i] = (v4u){0u, 0u, 0u, 0u}; vv[i] = (v4u){0u, 0u, 0u, 0u}; }
        }
#pragma unroll
        for (int i = 0; i < 4; ++i) *(LAS v4u*)(L + key * KS_STRIDE + (32 * half + 8 * i) * 2) = kv[i];
#pragma unroll
        for (int i = 0; i < 4; ++i)
#pragma unroll
            for (int c = 0; c < 4; ++c) { const unsigned wd = vv[i][c]; const int e = 32 * half + 8 * i + 2 * c;
                *(LAS u16*)(L + VT_OFF + e * VT_STRIDE + key * 2) = (u16)(wd & 0xffffu);
                *(LAS u16*)(L + VT_OFF + (e + 1) * VT_STRIDE + key * 2) = (u16)(wd >> 16); }
    }
    __syncthreads();
    const int q = lane & 15, g = lane >> 4;
    const int iq = 128 * qb + 16 * w + q;
    const size_t qrow = (size_t)b * SEQ + r + ((size_t)iq << dsh);
    const bf16x8 qf0 = *(const bf16x8*)(F.Qb() + qrow * 512 + h * 64 + 8 * g), qf1 = *(const bf16x8*)(F.Qb() + qrow * 512 + h * 64 + 32 + 8 * g);
    f32x4 s[9];
#pragma unroll
    for (int kt = 0; kt < 9; ++kt) {
        const int key = 16 * (w + kt) + q;
        const bf16x8 a0 = *(const LAS bf16x8*)(L + key * KS_STRIDE + (8 * g) * 2), a1 = *(const LAS bf16x8*)(L + key * KS_STRIDE + (32 + 8 * g) * 2);
        f32x4 acc = (f32x4){0.f, 0.f, 0.f, 0.f};
        acc = MFMA16(a0, qf0, acc); acc = MFMA16(a1, qf1, acc); s[kt] = acc;
    }
    float mx = -INFINITY;
#pragma unroll
    for (int kt = 0; kt < 9; ++kt)
#pragma unroll
        for (int rg = 0; rg < 4; ++rg) { const int cc = 16 * kt + 4 * g + rg; const bool ok = (cc >= q) && (cc <= q + 128) && (qb > 0 || 16 * w + cc >= 128);
            const float v = ok ? s[kt][rg] * 0.125f : -INFINITY; s[kt][rg] = v; mx = fmaxf(mx, v); }
    mx = fmaxf(mx, __shfl_xor(mx, 16)); mx = fmaxf(mx, __shfl_xor(mx, 32));
    float lsum = 0.f;
#pragma unroll
    for (int kt = 0; kt < 9; ++kt)
#pragma unroll
        for (int rg = 0; rg < 4; ++rg) { const float p = __expf(s[kt][rg] - mx); s[kt][rg] = p; lsum += p; }
    lsum += __shfl_xor(lsum, 16); lsum += __shfl_xor(lsum, 32);
    f32x4 o[4];
#pragma unroll
    for (int et = 0; et < 4; ++et) o[et] = (f32x4){0.f, 0.f, 0.f, 0.f};
    const f32x4 zero4 = (f32x4){0.f, 0.f, 0.f, 0.f};
#pragma unroll
    for (int p = 0; p < 5; ++p) {
        const bf16x8 pa = pack8(s[2 * p], p < 4 ? s[2 * p + 1] : zero4);
#pragma unroll
        for (int et = 0; et < 4; ++et) {
            const LAS unsigned char* vb = L + VT_OFF + (16 * et + q) * VT_STRIDE + (16 * w + 32 * p + 4 * g) * 2;
            const u32x2 lo = *(const LAS u32x2*)vb; u32x2 hi = (u32x2){0u, 0u}; if (p < 4) hi = *(const LAS u32x2*)(vb + 32);
            o[et] = MFMA16(pa, join8(lo, hi), o[et]);
        }
    }
#pragma unroll
    for (int rg = 0; rg < 4; ++rg) {
        const float lq = __shfl(lsum, 4 * g + rg), mq = __shfl(mx, 4 * g + rg);
        const int iq2 = 128 * qb + 16 * w + 4 * g + rg;
        const size_t row = (size_t)b * SEQ + r + ((size_t)iq2 << dsh);
        const float inv = 1.0f / lq;
        float* op = F.Opart() + ((size_t)di * MP + row) * 512 + h * 64 + q;
#pragma unroll
        for (int et = 0; et < 4; ++et) op[16 * et] = o[et][rg] * inv;
        if (q == 0) F.Lse()[((size_t)di * MP + row) * 8 + h] = mq + __logf(lq);
    }
    __syncthreads();
}
__device__ __forceinline__ void attn_combine_rows(const Ctx& F) {
    const int gw = F.bid * NWAVES + F.wave, NGW = F.G * NWAVES, lane = F.lane, h = lane >> 3;
    for (int m = gw; m < MP; m += NGW) {
        float ls[3], wt[3];
#pragma unroll
        for (int i = 0; i < 3; ++i) ls[i] = F.Lse()[((size_t)i * MP + m) * 8 + h];
        const float mxl = fmaxf(ls[0], fmaxf(ls[1], ls[2])); float den = 0.f;
#pragma unroll
        for (int i = 0; i < 3; ++i) { wt[i] = __expf(ls[i] - mxl); den += wt[i]; }
        const float rden = 1.0f / den;
        f32x4 a0 = (f32x4){0.f, 0.f, 0.f, 0.f}, a1 = a0;
#pragma unroll
        for (int i = 0; i < 3; ++i) { const f32x4* p = (const f32x4*)(F.Opart() + ((size_t)i * MP + m) * 512 + lane * 8); a0 += p[0] * (wt[i] * rden); a1 += p[1] * (wt[i] * rden); }
        v4u o; o.x = pk2(a0[0], a0[1]); o.y = pk2(a0[2], a0[3]); o.z = pk2(a1[0], a1[1]); o.w = pk2(a1[2], a1[3]);
        *(v4u*)(F.Cat() + (size_t)m * 1024 + lane * 8) = o;
    }
}
__device__ __forceinline__ const float* samp_row(const float* cache, const float* onew, int bd, int idx, int h) {
    return idx < 2048 ? cache + ((size_t)(bd * 2048 + idx) * 512 + h * 64) : onew + ((size_t)(bd * 2048 + 2044 + (idx - 2048)) * 512 + h * 64);
}
__device__ __forceinline__ void attn_sample_unit(const Ctx& F, int u) {
    const int bd = u >> 3, h = u & 7, tid = F.tid, lane = F.lane, w = F.wave;
    LAS float* sc = (LAS float*)F.lds;
    LAS float* stt = (LAS float*)(F.lds + 6400);
    LAS float* red = (LAS float*)(F.lds + 8192);
    const int grp = tid >> 4, li = tid & 15;
    const float* okn = F.out + O_KS; const float* ovn = F.out + O_VS;
#pragma unroll 1
    for (int s = 0; s < 4; ++s) {
        const u32x2 qw = *(const u32x2*)(F.Qb() + (size_t)(MP + bd * 4 + s) * 512 + h * 64 + 4 * li);
        const f32x4 qv = (f32x4){bf2f(qw.x & 0xffffu), bf2f(qw.x >> 16), bf2f(qw.y & 0xffffu), bf2f(qw.y >> 16)} * 0.125f;
#pragma unroll
        for (int n = 0; n < 13; ++n) {
            const int it = grp + 32 * n;
            if (it < 387) {
                const int di = it / 129, j = it - di * 129, idx = 2048 + s - (j << (2 * di));
                const f32x4 kk = *(const f32x4*)(samp_row(F.ck, okn, bd, idx, h) + 4 * li);
                float dot = (qv[0] * kk[0] + qv[1] * kk[1]) + (qv[2] * kk[2] + qv[3] * kk[3]);
                dot += __shfl_xor(dot, 1); dot += __shfl_xor(dot, 2); dot += __shfl_xor(dot, 4); dot += __shfl_xor(dot, 8);
                if (li == 0) sc[(s * 3 + di) * 132 + j] = dot;
            }
        }
    }
    __syncthreads();
    for (int c = w; c < 12; c += 8) {
        const float v0 = sc[c * 132 + lane], v1 = sc[c * 132 + 64 + lane], v2 = (lane == 0) ? sc[c * 132 + 128] : -INFINITY;
        float mx = fmaxf(v0, fmaxf(v1, v2));
#pragma unroll
        for (int o = 1; o < 64; o <<= 1) mx = fmaxf(mx, __shfl_xor(mx, o));
        const float p0 = __expf(v0 - mx), p1 = __expf(v1 - mx), p2 = (lane == 0) ? __expf(v2 - mx) : 0.f;
        const float l = wave_sum(p0 + p1 + p2);
        sc[c * 132 + lane] = p0; sc[c * 132 + 64 + lane] = p1; if (lane == 0) { sc[c * 132 + 128] = p2; stt[2 * c] = mx; stt[2 * c + 1] = l; }
    }
    __syncthreads();
#pragma unroll 1
    for (int s = 0; s < 4; ++s) {
        float coef[3];
        { float ls[3], mxl = -INFINITY, den = 0.f;
#pragma unroll
          for (int i = 0; i < 3; ++i) { ls[i] = stt[2 * (s * 3 + i)] + __logf(stt[2 * (s * 3 + i) + 1]); mxl = fmaxf(mxl, ls[i]); }
#pragma unroll
          for (int i = 0; i < 3; ++i) { coef[i] = __expf(ls[i] - mxl); den += coef[i]; }
#pragma unroll
          for (int i = 0; i < 3; ++i) coef[i] = coef[i] / (den * stt[2 * (s * 3 + i) + 1]); }
        f32x4 acc = (f32x4){0.f, 0.f, 0.f, 0.f};
#pragma unroll
        for (int n = 0; n < 13; ++n) {
            const int it = grp + 32 * n;
            if (it < 387) {
                const int di = it / 129, j = it - di * 129, idx = 2048 + s - (j << (2 * di));
                const f32x4 vv = *(const f32x4*)(samp_row(F.cv, ovn, bd, idx, h) + 4 * li);
                const float p = sc[(s * 3 + di) * 132 + j] * (di == 0 ? coef[0] : (di == 1 ? coef[1] : coef[2]));
                acc += vv * p;
            }
        }
        *(LAS f32x4*)(red + (s * 32 + grp) * 64 + 4 * li) = acc;
    }
    __syncthreads();
    if (tid < 256) {
        const int s = tid >> 6, e = tid & 63; float a = 0.f;
        for (int gI = 0; gI < 32; ++gI) a += red[(s * 32 + gI) * 64 + e];
        F.Cat()[(size_t)(MP + bd * 4 + s) * 1024 + h * 64 + e] = (bf16)f2bf(a);
    }
    __syncthreads();
}
__device__ __forceinline__ void hgrn_sample_unit(const Ctx& F, int u) {
    const int bd = u >> 2, hh = u & 3, tid = F.tid, lane = F.lane, w = F.wave;
    LAS float* part = (LAS float*)F.lds;
    LAS float* ssq = (LAS float*)(F.lds + 32768);
    const int v4 = tid & 31, kq = tid >> 5;
    const float* sp = F.st0 + ((size_t)u * 128 + 8 * kq) * 128 + 4 * v4;
    float* so = F.out + O_SS + ((size_t)u * 128 + 8 * kq) * 128 + 4 * v4;
    f32x4 S[8];
#pragma unroll
    for (int i = 0; i < 8; ++i) S[i] = *(const f32x4*)(sp + (size_t)i * 128);
#pragma unroll
    for (int s = 0; s < 4; ++s) {
        const size_t base = (size_t)(MP + bd * 4 + s) * 512 + hh * 128;
        const f32x4 kh0 = *(const f32x4*)(F.KH() + base + 8 * kq), kh1 = *(const f32x4*)(F.KH() + base + 8 * kq + 4);
        const f32x4 q0 = *(const f32x4*)(F.HQ() + base + 8 * kq), q1 = *(const f32x4*)(F.HQ() + base + 8 * kq + 4);
        const f32x4 iv = *(const f32x4*)(F.HI() + base + 4 * v4);
        f32x4 po = (f32x4){0.f, 0.f, 0.f, 0.f};
#pragma unroll
        for (int i = 0; i < 8; ++i) { const float kh = i < 4 ? kh0[i & 3] : kh1[i & 3], qq = i < 4 ? q0[i & 3] : q1[i & 3];
            S[i] = S[i] * (1.0f - kh) + iv * kh; po += S[i] * qq; }
        *(LAS f32x4*)(part + (s * 16 + kq) * 128 + 4 * v4) = po;
    }
#pragma unroll
    for (int i = 0; i < 8; ++i) *(f32x4*)(so + (size_t)i * 128) = S[i];
    __syncthreads();
    const int s = tid >> 7, v = tid & 127; float o = 0.f;
#pragma unroll
    for (int k2 = 0; k2 < 16; ++k2) o += part[(s * 16 + k2) * 128 + v];
    const float sq = wave_sum(o * o);
    if (lane == 0) ssq[w] = sq;
    __syncthreads();
    const float tot = ssq[2 * s] + ssq[2 * s + 1];
    const float rstd = 1.0f / sqrtf(tot * (1.0f / 128.0f) + LN_EPS);
    const size_t row = (size_t)(MP + bd * 4 + s); const int col = hh * 128 + v;
    F.Cat()[row * 1024 + 512 + col] = (bf16)f2bf(o * rstd * F.hng[col] * F.HG()[row * 512 + col]);
    __syncthreads();
}
constexpr int HG_QD = 0, HG_KD = 8704, HG_KET = 17408, HG_VT = 27648, HG_DEC = 37888, HG_QT = 38400, HG_SSQ = 40448;
template <bool FULL>
__device__ __forceinline__ float hgrn_prep(const Ctx& F, int b, int hh, int t0) {
    LAS unsigned char* L = F.lds; const int tid = F.tid, k = tid & 127, tq = tid >> 7;
    const size_t rbase = ((size_t)b * SEQ + t0 + 8 * tq) * 512 + hh * 128 + k;
    float cum[8];
#pragma unroll
    for (int i = 0; i < 8; ++i) cum[i] = F.LOGF()[rbase + (size_t)i * 512];
#pragma unroll
    for (int i = 1; i < 8; ++i) cum[i] += cum[i - 1];
    LAS float* QT = (LAS float*)(L + HG_QT);
    QT[tq * 128 + k] = cum[7];
    __syncthreads();
    float off = 0.f, tot = 0.f;
#pragma unroll
    for (int q2 = 0; q2 < 4; ++q2) { const float v = QT[q2 * 128 + k]; off += (q2 < tq) ? v : 0.f; tot += v; }
#pragma unroll
    for (int i = 0; i < 8; ++i) {
        const float c = cum[i] + off; const int t = 8 * tq + i;
        const float kh = F.KH()[rbase + (size_t)i * 512];
        if (FULL) { const float qv = F.HQ()[rbase + (size_t)i * 512];
            *(LAS u16*)(L + HG_QD + t * 272 + k * 2) = (u16)f2bf(qv * __expf(c));
            *(LAS u16*)(L + HG_KD + t * 272 + k * 2) = (u16)f2bf(kh * __expf(-c)); }
        *(LAS u16*)(L + HG_KET + k * 80 + t * 2) = (u16)f2bf(kh * __expf(tot - c));
        *(LAS u16*)(L + HG_VT + k * 80 + t * 2) = (u16)f2bf(F.HI()[rbase + (size_t)i * 512]);
    }
    if (tq == 0) *(LAS float*)(L + HG_DEC + k * 4) = __expf(tot);
    __syncthreads();
    return tot;
}
__device__ __forceinline__ void hgrn_update(const Ctx& F, f32x4 (&S)[8]) {
    LAS unsigned char* L = F.lds; const int c16 = F.lane & 15, g = F.lane >> 4, w = F.wave;
    const bf16x8 vB = *(const LAS bf16x8*)(L + HG_VT + (16 * w + c16) * 80 + (8 * g) * 2);
#pragma unroll
    for (int a = 0; a < 8; ++a) {
        const f32x4 dc = *(const LAS f32x4*)(L + HG_DEC + (16 * a + 4 * g) * 4);
        const bf16x8 keA = *(const LAS bf16x8*)(L + HG_KET + (16 * a + c16) * 80 + (8 * g) * 2);
        S[a] = MFMA16(keA, vB, S[a] * dc);
    }
}
__device__ __forceinline__ void hgrn_pass1_unit(const Ctx& F, int u) {
    const int bh = u >> 4, seg = u & 15, b = bh >> 2, hh = bh & 3;
    f32x4 S[8];
#pragma unroll
    for (int a = 0; a < 8; ++a) S[a] = (f32x4){0.f, 0.f, 0.f, 0.f};
    float dsum = 0.f;
    for (int c = 0; c < 8; ++c) { dsum += hgrn_prep<false>(F, b, hh, seg * 256 + c * 32); hgrn_update(F, S); __syncthreads(); }
    if (F.tid < 128) F.Dseg()[(size_t)u * 128 + F.tid] = __expf(dsum);
#pragma unroll
    for (int a = 0; a < 8; ++a) *(f32x4*)(F.Useg() + ((((size_t)u * 8 + F.wave) * 8 + a) * 64 + F.lane) * 4) = S[a];
}
__device__ __forceinline__ void hgrn_pass2_unit(const Ctx& F, int u) {
    LAS unsigned char* L = F.lds;
    const int bh = u >> 4, seg = u & 15, b = bh >> 2, hh = bh & 3, lane = F.lane, w = F.wave, c16 = lane & 15, g = lane >> 4;
    f32x4 S[8];
#pragma unroll
    for (int a = 0; a < 8; ++a) S[a] = (f32x4){0.f, 0.f, 0.f, 0.f};
    for (int sp = 0; sp < seg; ++sp) { const size_t pu = (size_t)bh * 16 + sp;
#pragma unroll
        for (int a = 0; a < 8; ++a) { const f32x4 dc = *(const f32x4*)(F.Dseg() + pu * 128 + 16 * a + 4 * g); const f32x4 U = *(const f32x4*)(F.Useg() + (((pu * 8 + w) * 8 + a) * 64 + lane) * 4); S[a] = S[a] * dc + U; } }
    for (int c = 0; c < 8; ++c) {
        const int t0 = seg * 256 + c * 32;
        (void)hgrn_prep<true>(F, b, hh, t0);
        f32x4 am[2][2];
#pragma unroll
        for (int jt = 0; jt < 2; ++jt)
#pragma unroll
            for (int it = 0; it < 2; ++it) am[jt][it] = (f32x4){0.f, 0.f, 0.f, 0.f};
#pragma unroll
        for (int s4 = 0; s4 < 4; ++s4) {
            bf16x8 kdA[2], qdB[2];
#pragma unroll
            for (int t2 = 0; t2 < 2; ++t2) { kdA[t2] = *(const LAS bf16x8*)(L + HG_KD + (16 * t2 + c16) * 272 + (32 * s4 + 8 * g) * 2); qdB[t2] = *(const LAS bf16x8*)(L + HG_QD + (16 * t2 + c16) * 272 + (32 * s4 + 8 * g) * 2); }
#pragma unroll
            for (int jt = 0; jt < 2; ++jt)
#pragma unroll
                for (int it = 0; it < 2; ++it) am[jt][it] = MFMA16(kdA[jt], qdB[it], am[jt][it]);
        }
#pragma unroll
        for (int jt = 0; jt < 2; ++jt)
#pragma unroll
            for (int it = 0; it < 2; ++it)
#pragma unroll
                for (int rg = 0; rg < 4; ++rg) if (16 * jt + 4 * g + rg > 16 * it + c16) am[jt][it][rg] = 0.f;
        f32x4 o[2];
        { const LAS unsigned char* vb = L + HG_VT + (16 * w + c16) * 80 + (4 * g) * 2;
          const bf16x8 vB = join8(*(const LAS u32x2*)vb, *(const LAS u32x2*)(vb + 32));
#pragma unroll
          for (int it = 0; it < 2; ++it) o[it] = MFMA16(pack8(am[0][it], am[1][it]), vB, ((f32x4){0.f, 0.f, 0.f, 0.f})); }
#pragma unroll
        for (int kp = 0; kp < 4; ++kp) {
            const bf16x8 sB = pack8(S[2 * kp], S[2 * kp + 1]);
#pragma unroll
            for (int it = 0; it < 2; ++it) { const LAS unsigned char* qp = L + HG_QD + (16 * it + c16) * 272 + (32 * kp + 4 * g) * 2;
                o[it] = MFMA16(join8(*(const LAS u32x2*)qp, *(const LAS u32x2*)(qp + 32)), sB, o[it]); }
        }
        hgrn_update(F, S);
        LAS float* SSQ = (LAS float*)(L + HG_SSQ);
#pragma unroll
        for (int it = 0; it < 2; ++it)
#pragma unroll
            for (int rg = 0; rg < 4; ++rg) { float sq = o[it][rg] * o[it][rg]; sq += __shfl_xor(sq, 1); sq += __shfl_xor(sq, 2); sq += __shfl_xor(sq, 4); sq += __shfl_xor(sq, 8);
                if (c16 == 0) SSQ[w * 32 + 16 * it + 4 * g + rg] = sq; }
        __syncthreads();
        const int col = hh * 128 + 16 * w + c16; const float ng = F.hng[col];
#pragma unroll
        for (int it = 0; it < 2; ++it)
#pragma unroll
            for (int rg = 0; rg < 4; ++rg) { const int i = 16 * it + 4 * g + rg; float tot = 0.f;
#pragma unroll
                for (int w2 = 0; w2 < 8; ++w2) tot += SSQ[w2 * 32 + i];
                const float rstd = 1.0f / sqrtf(tot * (1.0f / 128.0f) + LN_EPS);
                const size_t row = (size_t)b * SEQ + t0 + i;
                F.Cat()[row * 1024 + 512 + col] = (bf16)f2bf(o[it][rg] * rstd * ng * F.HG()[row * 512 + col]); }
        __syncthreads();
    }
    if (seg == 15) {
#pragma unroll
        for (int a = 0; a < 8; ++a)
#pragma unroll
            for (int rg = 0; rg < 4; ++rg) F.out[O_SP + ((size_t)bh * 128 + 16 * a + 4 * g + rg) * 128 + 16 * w + c16] = S[a][rg];
    }
}
struct Args { const float* in[21]; float* out; unsigned char* ws; };
__global__ void __launch_bounds__(NWAVES * 64, 2) fwd_kernel(Args args) {
    extern __shared__ __attribute__((aligned(16))) unsigned char lds[];
    Ctx F;
    F.lds = (LAS unsigned char*)lds;
    const int wave_s = __builtin_amdgcn_readfirstlane((int)threadIdx.x >> 6);
    F.tid = threadIdx.x; F.lane = F.tid & 63; F.wave = wave_s; F.G = gridDim.x; F.bid = blockIdx.x;
    F.xp = args.in[0]; F.xs = args.in[1]; F.ck = args.in[2]; F.cv = args.in[3]; F.st0 = args.in[4]; F.w1g = args.in[5]; F.w1u = args.in[6]; F.w1d = args.in[7]; F.ln1g = args.in[8]; F.ln1b = args.in[9];
    F.win = args.in[10]; F.hlb = args.in[11]; F.hng = args.in[12]; F.wout = args.in[13]; F.ln2g = args.in[14]; F.ln2b = args.in[15]; F.w2g = args.in[16]; F.w2u = args.in[17]; F.w2d = args.in[18]; F.ln3g = args.in[19]; F.ln3b = args.in[20];
    F.out = args.out; F.ws = args.ws; unsigned char* ws = args.ws;


    for (int u = F.tid; u < (LDS_BYTES - LDSCTL_OFF) / 4; u += NWAVES * 64) ((LAS unsigned*)(F.lds + LDSCTL_OFF))[u] = 0u;
    __syncthreads();
    XcdBarrier bar = xcd_barrier_post((unsigned*)(ws + WS_CTL) + CW_BAR, (volatile LAS unsigned*)(F.lds + MISC_OFF) + 8);
#define REFRESH() do { int l_ = (int)__builtin_amdgcn_mbcnt_hi(~0u, __builtin_amdgcn_mbcnt_lo(~0u, 0u)); asm volatile("" : "+v"(l_)); F.lane = l_; F.wave = wave_s; F.tid = wave_s * 64 + l_; } while (0)
#define GRID_BAR() do { xcd_barrier(bar); REFRESH(); } while (0)
#define COPY_SETUP(S, off4, n4_, R) do { const int cb_ = F.bid & 127; const float* sp_ = (F.bid < 128 ? F.ck : F.cv) + (size_t)cb_ * 1048576 + 2048; float* dp_ = F.out + (F.bid < 128 ? O_KS : O_VS) + (size_t)cb_ * 1048576; \
        (S).src = (const f32x4*)sp_ + (off4); (S).dst = (f32x4*)dp_ + (off4); (S).n4 = (F.G == 256) ? (n4_) : 0; (S).slot = (F.bid >> 3) % (R); (S).tid = F.tid; (S).cnt = 0; } while (0)

#if PHMASK & 1
    for (int rep_ = 0; rep_ < ((REPMASK & 1) ? 2 : 1); ++rep_) {
    p0_prologue(F);
    }
#endif
    GRID_BAR();
#if PHMASK & 2
    for (int rep_ = 0; rep_ < ((REPMASK & 2) ? 2 : 1); ++rep_) {
    { pg8::Gemm g{F.Xb(), F.W1gu(), M, NGU, D}; pg8::CopyOrder S; S.init(M, NGU, F.G, F.bid); COPY_SETUP(S, 0, 100352, 5); pg8::EpiSwiGLU E{F.Hb(), FF};
      pg8::gemm_phase<pg8::EpiSwiGLU, pg8::CopyOrder, true, true>(F.lds + RING_OFF, g, S, E, F.tid); }
    }
#endif
    GRID_BAR();
#if PHMASK & 4
    for (int rep_ = 0; rep_ < ((REPMASK & 4) ? 2 : 1); ++rep_) {
    { pg8::Gemm g{F.Hb(), F.W1d(), M, D, FF}; pg8::StaticOrder S; S.init(M, D, F.G, F.bid); pg8::EpiResid E{F.xp, F.xs, F.Ypre(), DN_ALPHA, 0.5f};
      pg8::gemm_phase<pg8::EpiResid, pg8::StaticOrder, true, true>(F.lds + RING_OFF, g, S, E, F.tid); }
    }
#endif
    GRID_BAR();
#if PHMASK & 8
    for (int rep_ = 0; rep_ < ((REPMASK & 8) ? 2 : 1); ++rep_) {
    ln_rows(F, F.Ypre(), F.ln1g, F.ln1b, F.X1(), F.X1b());
    }
#endif
    GRID_BAR();
#if PHMASK & 16
    for (int rep_ = 0; rep_ < ((REPMASK & 16) ? 2 : 1); ++rep_) {
    { pg8::Gemm g{F.X1b(), F.Win(), M, NIN, D}; pg8::CopyOrder S; S.init(M, NIN, F.G, F.bid); COPY_SETUP(S, 100352, 60928, 3);
      pg8::EpiWin E{F.Qb(), F.Kb(), F.Vb(), F.HQ(), F.LOGF(), F.KH(), F.HI(), F.HG(), F.COS(), F.SIN(), F.LB(), F.out + O_KP, F.out + O_VP, F.out + O_KS, F.out + O_VS};
      pg8::gemm_phase<pg8::EpiWin, pg8::CopyOrder, true, true>(F.lds + RING_OFF, g, S, E, F.tid); }
    }
#endif
    GRID_BAR();
#if PHMASK & 32
    for (int rep_ = 0; rep_ < ((REPMASK & 32) ? 2 : 1); ++rep_) {
    for (int u = F.bid; u < 256; u += F.G) hgrn_pass1_unit(F, u);
    }
#endif
#if PHMASK & 64
    for (int rep_ = 0; rep_ < ((REPMASK & 64) ? 2 : 1); ++rep_) {
    for (int u = F.bid; u < 3072; u += F.G) attn_prompt_unit(F, u);
    }
#endif
#if PHMASK & 128
    for (int rep_ = 0; rep_ < ((REPMASK & 128) ? 2 : 1); ++rep_) {
    for (int u = F.bid; u < 1024; u += F.G) attn_sample_unit(F, u);
    }
#endif
#if PHMASK & 256
    for (int rep_ = 0; rep_ < ((REPMASK & 256) ? 2 : 1); ++rep_) {
    for (int u = F.bid; u < 512; u += F.G) hgrn_sample_unit(F, u);
    }
#endif
    GRID_BAR();
#if PHMASK & 512
    for (int rep_ = 0; rep_ < ((REPMASK & 512) ? 2 : 1); ++rep_) {
    for (int u = F.bid; u < 256; u += F.G) hgrn_pass2_unit(F, u);
    }
#endif
#if PHMASK & 1024
    for (int rep_ = 0; rep_ < ((REPMASK & 1024) ? 2 : 1); ++rep_) {
    attn_combine_rows(F);
    }
#endif
    GRID_BAR();
#if PHMASK & 2048
    for (int rep_ = 0; rep_ < ((REPMASK & 2048) ? 2 : 1); ++rep_) {
    { pg8::Gemm g{F.Cat(), F.Wout(), M, D, D}; pg8::StaticOrder S; S.init(M, D, F.G, F.bid); pg8::EpiResid E{F.X1(), F.X1() + (size_t)MP * D, F.Ypre(), DN_ALPHA, 1.0f};
      pg8::gemm_phase<pg8::EpiResid, pg8::StaticOrder, true, true>(F.lds + RING_OFF, g, S, E, F.tid); }
    }
#endif
    GRID_BAR();
    ln_rows(F, F.Ypre(), F.ln2g, F.ln2b, F.X2(), F.X2b());
    GRID_BAR();
    { pg8::Gemm g{F.X2b(), F.W2gu(), M, NGU, D}; pg8::CopyOrder S; S.init(M, NGU, F.G, F.bid); COPY_SETUP(S, 161280, 100352, 5); pg8::EpiSwiGLU E{F.Hb(), FF};
      pg8::gemm_phase<pg8::EpiSwiGLU, pg8::CopyOrder, true, true>(F.lds + RING_OFF, g, S, E, F.tid); }
    GRID_BAR();
    { pg8::Gemm g{F.Hb(), F.W2d(), M, D, FF}; pg8::StaticOrder S; S.init(M, D, F.G, F.bid); pg8::EpiResid E{F.X2(), F.X2() + (size_t)MP * D, F.Ypre(), DN_ALPHA, 0.5f};
      pg8::gemm_phase<pg8::EpiResid, pg8::StaticOrder, true, true>(F.lds + RING_OFF, g, S, E, F.tid); }
    GRID_BAR();
    ln_rows(F, F.Ypre(), F.ln3g, F.ln3b, F.out + O_YP, (bf16*)nullptr);
}
#if DBG
constexpr int DBG_NST = 14, DBG_NS = 6;
__device__ __forceinline__ unsigned dhash(unsigned x) { x ^= x >> 16; x *= 0x7feb352dU; x ^= x >> 15; x *= 0x846ca68bU; x ^= x >> 16; return x; }
__device__ __forceinline__ float dbf(bf16 h) { return bf2f((unsigned)h); }
__device__ __forceinline__ float rbf(float x) { return bf2f(f2bf(x)); }
__device__ __forceinline__ float dsig(float x) { return 1.0f / (1.0f + __expf(-x)); }
__device__ __forceinline__ void dmax(unsigned* slot, float e) { unsigned b = (e != e) ? 0x7fc00000u : __builtin_bit_cast(unsigned, fabsf(e)); atomicMax(slot, b); }
__device__ __forceinline__ float block_sum1024(float v, float* sh) {
    v = wave_sum(v); __syncthreads(); if ((threadIdx.x & 63) == 0) sh[threadIdx.x >> 6] = v; __syncthreads(); float t = 0.f; for (int i = 0; i < 16; ++i) t += sh[i]; __syncthreads(); return t;
}
__device__ void dbg_ffn_row(const float* res, const bf16* xb, const bf16* Wgu, const bf16* Wd, const float* lg, const float* lb, const float* got, unsigned* slot, float* hs, float* ys, float* sh) {
    const int tid = threadIdx.x;
    for (int hc = tid; hc < FF; hc += 1024) {
        const bf16* wg = Wgu + (size_t)(256 * (hc >> 7) + (hc & 127)) * D; const bf16* wu = wg + (size_t)128 * D; float g = 0.f, u = 0.f;
        for (int k = 0; k < D; ++k) { const float x = dbf(xb[k]); g += x * dbf(wg[k]); u += x * dbf(wu[k]); }
        hs[hc] = rbf(g * dsig(g) * u);
    }
    __syncthreads();
    float acc = 0.f; { const bf16* wd = Wd + (size_t)tid * FF; for (int j = 0; j < FF; ++j) acc += hs[j] * dbf(wd[j]); }
    const float y = DN_ALPHA * res[tid] + 0.5f * acc;
    const float mean = block_sum1024(y, sh) * (1.f / D); const float var = block_sum1024((y - mean) * (y - mean), sh) * (1.f / D);
    const float want = (y - mean) / sqrtf(var + LN_EPS) * lg[tid] + lb[tid];
    dmax(slot, (got[tid] - want)); (void)ys;
}
__global__ void __launch_bounds__(1024, 1) dbg_check(Args args) {
    __shared__ float hs[FF]; __shared__ float ys[1024]; __shared__ float sh[64]; __shared__ float ov[128];
    Ctx F; unsigned char* ws = args.ws;
    F.xp = args.in[0]; F.xs = args.in[1]; F.ck = args.in[2]; F.cv = args.in[3]; F.st0 = args.in[4]; F.w1g = args.in[5]; F.w1u = args.in[6]; F.w1d = args.in[7]; F.ln1g = args.in[8]; F.ln1b = args.in[9];
    F.win = args.in[10]; F.hlb = args.in[11]; F.hng = args.in[12]; F.wout = args.in[13]; F.ln2g = args.in[14]; F.ln2b = args.in[15]; F.w2g = args.in[16]; F.w2u = args.in[17]; F.w2d = args.in[18]; F.ln3g = args.in[19]; F.ln3b = args.in[20];
    F.out = args.out; F.ws = ws;


    unsigned* DB = (unsigned*)(ws + WS_DBG);
    const int stage = blockIdx.x / DBG_NS, smp = blockIdx.x % DBG_NS, tid = threadIdx.x;
    unsigned* slot = DB + stage;
    const unsigned hb = dhash(blockIdx.x * 7919u + 13u), ht = dhash(hb + tid * 2654435761u);
    if (stage == 0) {
        { const int c = ht % FF, k = dhash(ht + 1) % D; dmax(slot, dbf(F.W1gu()[(size_t)(256 * (c >> 7) + (c & 127)) * D + k]) - rbf(F.w1g[(size_t)k * FF + c])); dmax(slot, dbf(F.W1gu()[(size_t)(256 * (c >> 7) + 128 + (c & 127)) * D + k]) - rbf(F.w1u[(size_t)k * FF + c]));
          dmax(slot, dbf(F.W2gu()[(size_t)(256 * (c >> 7) + (c & 127)) * D + k]) - rbf(F.w2g[(size_t)k * FF + c])); dmax(slot, dbf(F.W2gu()[(size_t)(256 * (c >> 7) + 128 + (c & 127)) * D + k]) - rbf(F.w2u[(size_t)k * FF + c])); }
        { const int c = ht % D, k = dhash(ht + 2) % FF; dmax(slot, dbf(F.W1d()[(size_t)c * FF + k]) - rbf(F.w1d[(size_t)k * D + c])); dmax(slot, dbf(F.W2d()[(size_t)c * FF + k]) - rbf(F.w2d[(size_t)k * D + c])); }
        { const int c = ht % NIN, k = dhash(ht + 3) % D; dmax(slot, dbf(F.Win()[(size_t)RmWin()(c) * D + k]) - rbf(F.win[(size_t)k * NIN + c])); }
        { const int c = ht % D, k = dhash(ht + 4) % D; dmax(slot, dbf(F.Wout()[(size_t)c * D + k]) - rbf(F.wout[(size_t)k * D + c])); }
    } else if (stage == 1) {
        const int m = ht % M, c = dhash(ht + 1) % D; const float x = m < MP ? F.xp[(size_t)m * D + c] : F.xs[(size_t)(m - MP) * D + c]; dmax(slot, dbf(F.Xb()[(size_t)m * D + c]) - rbf(x));
    } else if (stage == 2) {
        const int pi = (smp == 0 && tid < 8) ? 4092 + tid : (int)(ht % 4100), i = dhash(ht + 1) & 31; const int pos = pi < 4096 ? pi : 8192 + (pi - 4096);
        const float ang = (float)pos * INV_FREQ[i]; double r = (double)ang; r -= 6.283185307179586 * __builtin_rint(r * 0.15915494309189535);
        double sn = 0., cs = 0., term = 1.; for (int n = 0; n < 30; ++n) { if (n & 1) sn += ((n >> 1) & 1) ? -term : term; else cs += ((n >> 1) & 1) ? -term : term; term *= r / (double)(n + 1); }
        dmax(slot, F.COS()[pi * 32 + i] - (float)cs); dmax(slot, F.SIN()[pi * 32 + i] - (float)sn);
    } else if (stage == 3) {
        if (tid < 512) { const float a0 = F.hlb[tid], a1 = F.hlb[512 + tid]; dmax(slot, F.LB()[tid] - 1.0f / (1.0f + expf(a1 - a0))); }
    } else if (stage == 4) {
        const int b = ht & 127, rr = dhash(ht + 1) % 2044, c = dhash(ht + 2) & 511;
        dmax(slot, F.out[O_KS + ((size_t)b * 2048 + rr) * 512 + c] - F.ck[((size_t)b * 2048 + rr + 4) * 512 + c]); dmax(slot, F.out[O_VS + ((size_t)b * 2048 + rr) * 512 + c] - F.cv[((size_t)b * 2048 + rr + 4) * 512 + c]);
    } else if (stage == 5 || stage == 13) {
        const int m = (smp < 4) ? (int)(hb % MP) : MP + (int)(hb % MS);
        if (stage == 5) dbg_ffn_row(m < MP ? F.xp + (size_t)m * D : F.xs + (size_t)(m - MP) * D, F.Xb() + (size_t)m * D, F.W1gu(), F.W1d(), F.ln1g, F.ln1b, F.X1() + (size_t)m * D, slot, hs, ys, sh);
        else dbg_ffn_row(F.X2() + (size_t)m * D, F.X2b() + (size_t)m * D, F.W2gu(), F.W2d(), F.ln3g, F.ln3b, F.out + O_YP + (size_t)m * D, slot, hs, ys, sh);
    } else if (stage == 6) {
        const int m = (tid & 3) ? (int)(ht % MP) : ((tid & 4) ? MP + (int)(ht % MS) : (int)((ht % 4) * SEQ + 2048 + (dhash(ht + 9) % 2048))); const int col = dhash(ht + 1) % NIN;
        const int typ = col >> 9, c5 = col & 511; const bf16* xr = F.X1b() + (size_t)m * D;
        const int pi = m < MP ? (m & 4095) : 4096 + ((m - MP) & 3);
        float* fk = nullptr; if (m >= MP) fk = F.out + ((size_t)(((m - MP) >> 2) * 2048 + 2044 + ((m - MP) & 3))) * 512; else if ((m & 4095) >= 2048) fk = F.out + ((size_t)((m >> 12) * 2048 + (m & 4095) - 2048)) * 512;
        if (typ <= 1) {
            const int e = c5 & 63, e1 = e & 31, cb = col - e; float x1 = 0.f, x2 = 0.f; const bf16* w1 = F.Win() + (size_t)RmWin()(cb + e1) * D; const bf16* w2 = F.Win() + (size_t)RmWin()(cb + e1 + 32) * D;
            for (int k = 0; k < D; ++k) { const float x = dbf(xr[k]); x1 += x * dbf(w1[k]); x2 += x * dbf(w2[k]); }
            const float cs = F.COS()[pi * 32 + e1], sn = F.SIN()[pi * 32 + e1]; const float want = e < 32 ? x1 * cs - x2 * sn : x2 * cs + x1 * sn;
            const float got = dbf((typ == 0 ? F.Qb() : F.Kb())[(size_t)m * 512 + c5]); dmax(slot, (got - want) / (fabsf(want) + 0.2f));
            if (typ == 1 && fk) dmax(slot, (fk[(m >= MP ? O_KS : O_KP) + c5] - want) / (fabsf(want) + 0.2f));
        } else {
            float z = 0.f; const bf16* w1 = F.Win() + (size_t)col * D; for (int k = 0; k < D; ++k) z += dbf(xr[k]) * dbf(w1[k]);
            const size_t off = (size_t)m * 512 + c5;
            if (typ == 2) { dmax(slot, (dbf(F.Vb()[off]) - z) / (fabsf(z) + 0.1f)); if (fk) dmax(slot, (fk[(m >= MP ? O_VS : O_VP) + c5] - z) / (fabsf(z) + 0.1f)); }
            else if (typ == 3) dmax(slot, (F.HQ()[off] - z * dsig(z)) / (fabsf(z) + 0.1f));
            else if (typ == 4) { const float lb = 1.0f / (1.0f + expf(F.hlb[512 + c5] - F.hlb[c5])); const float f = lb + (1.f - lb) * dsig(z); dmax(slot, F.LOGF()[off] - logf(f)); dmax(slot, F.KH()[off] - (1.f - f)); }
            else if (typ == 5) dmax(slot, (F.HI()[off] - z) / (fabsf(z) + 0.1f));
            else dmax(slot, (F.HG()[off] - z * dsig(z)) / (fabsf(z) + 0.1f));
        }
    } else if (stage == 7 || stage == 8) {
        const int wv = tid >> 6, e = tid & 63; const unsigned hw = dhash(hb + wv * 977u);
        const int h = hw & 7; int m; if (stage == 7) { const int tsel = (wv & 3) == 0 ? (int)(dhash(hw + 1) % 140) : (int)(dhash(hw + 1) % SEQ); m = (int)(dhash(hw + 2) % 4) * SEQ + tsel; } else m = MP + (int)(dhash(hw + 1) % MS);
        const float qe = dbf(F.Qb()[(size_t)m * 512 + h * 64 + e]);
        float lse[3], ob[3];
        for (int di = 0; di < 3; ++di) {
            const int d = 1 << (2 * di); float mx = -INFINITY, l = 0.f, acc = 0.f;
            for (int j = 0; j <= 128; ++j) {
                float kv, vv;
                if (stage == 7) { const int t = (m & 4095) - d * j; if (t < 0) break; const size_t r = (size_t)(m - (m & 4095) + t) * 512 + h * 64 + e; kv = dbf(F.Kb()[r]); vv = dbf(F.Vb()[r]); }
                else { const int bd = (m - MP) >> 2, s = (m - MP) & 3, idx = 2048 + s - d * j; const size_t r = idx < 2048 ? ((size_t)(bd * 2048 + idx) * 512 + h * 64 + e) : ((size_t)(bd * 2048 + 2044 + idx - 2048) * 512 + h * 64 + e);
                       kv = idx < 2048 ? F.ck[r] : F.out[O_KS + r]; vv = idx < 2048 ? F.cv[r] : F.out[O_VS + r]; }
                const float sc = wave_sum(qe * kv) * 0.125f; const float nm = fmaxf(mx, sc); const float corr = __expf(mx - nm), p = __expf(sc - nm); l = l * corr + p; acc = acc * corr + p * vv; mx = nm;
            }
            lse[di] = mx + logf(l); ob[di] = acc / l;
        }
        const float ml = fmaxf(lse[0], fmaxf(lse[1], lse[2])); const float w0 = __expf(lse[0] - ml), w1 = __expf(lse[1] - ml), w2 = __expf(lse[2] - ml);
        const float want = (w0 * ob[0] + w1 * ob[1] + w2 * ob[2]) / (w0 + w1 + w2);
        dmax(slot, (dbf(F.Cat()[(size_t)m * 1024 + h * 64 + e]) - want) / (fabsf(want) + 0.05f));
    } else if (stage == 9 || stage == 10) {
        const int k = tid & 127, vg = tid >> 7; float S[16];
        int b = 0, hh = hb & 3, tt = 0, nstep; size_t row0;
        if (stage == 9) { b = (hb >> 2) & 3; tt = smp == 0 ? 3 : smp == 1 ? 40 : smp == 2 ? 300 : smp == 3 ? 1500 : smp == 4 ? 4095 : 2047; nstep = tt + 1; row0 = (size_t)b * SEQ;
#pragma unroll
            for (int i = 0; i < 16; ++i) S[i] = 0.f; }
        else { b = (hb >> 2) & 127; nstep = 4; tt = 3; row0 = (size_t)MP + b * 4;
#pragma unroll
            for (int i = 0; i < 16; ++i) S[i] = F.st0[((size_t)(b * 4 + hh) * 128 + k) * 128 + 16 * vg + i]; }
        for (int t = 0; t < nstep; ++t) { const size_t base = (row0 + t) * 512 + hh * 128; const float kh = F.KH()[base + k], f = __expf(F.LOGF()[base + k]);
#pragma unroll
            for (int i = 0; i < 16; ++i) S[i] = f * S[i] + kh * F.HI()[base + 16 * vg + i];
            if (t == tt || stage == 10) {
                const float q = F.HQ()[base + k];
#pragma unroll
                for (int i = 0; i < 16; ++i) { const float ps = wave_sum(q * S[i]); if ((tid & 63) == 0) sh[(tid >> 6) * 1 + 0] = ps; __syncthreads(); if (k == 0) ov[16 * vg + i] = sh[2 * vg] + sh[2 * vg + 1]; __syncthreads(); }
                float ssq = 0.f; for (int v = 0; v < 128; ++v) ssq += ov[v] * ov[v];
                const float rstd = 1.0f / sqrtf(ssq / 128.f + LN_EPS);
                if (tid < 128) { const int col = hh * 128 + tid; const float want = ov[tid] * rstd * F.hng[col] * F.HG()[(row0 + t) * 512 + col]; dmax(slot, (dbf(F.Cat()[(row0 + t) * 1024 + 512 + col]) - want) / (fabsf(want) + 0.05f)); }
                __syncthreads();
            }
        }
        if (stage == 10) { for (int i = 0; i < 16; ++i) dmax(slot, (F.out[O_SS + ((size_t)(b * 4 + hh) * 128 + k) * 128 + 16 * vg + i] - S[i]) / (fabsf(S[i]) + 0.1f)); }
        else if (tt == 4095) { for (int i = 0; i < 16; ++i) dmax(slot, (F.out[O_SP + ((size_t)(b * 4 + hh) * 128 + k) * 128 + 16 * vg + i] - S[i]) / (fabsf(S[i]) + 0.1f)); }
    } else if (stage == 11) {
        const int m = (smp < 4) ? (int)(hb % MP) : MP + (int)(hb % MS); float acc = 0.f; const bf16* cr = F.Cat() + (size_t)m * D; const bf16* wr = F.Wout() + (size_t)tid * D;
        for (int k = 0; k < D; ++k) acc += dbf(cr[k]) * dbf(wr[k]);
        const float y = DN_ALPHA * F.X1()[(size_t)m * D + tid] + acc;
        const float mean = block_sum1024(y, sh) * (1.f / D); const float var = block_sum1024((y - mean) * (y - mean), sh) * (1.f / D);
        const float want = (y - mean) / sqrtf(var + LN_EPS) * F.ln2g[tid] + F.ln2b[tid];
        dmax(slot, F.X2()[(size_t)m * D + tid] - want); dmax(slot, dbf(F.X2b()[(size_t)m * D + tid]) - rbf(F.X2()[(size_t)m * D + tid]));
    } else if (stage == 12) {
        const int m = ht % M, hc = dhash(ht + 1) % FF; const bf16* xr = F.X2b() + (size_t)m * D; const bf16* wg = F.W2gu() + (size_t)(256 * (hc >> 7) + (hc & 127)) * D; const bf16* wu = wg + (size_t)128 * D; float g = 0.f, u = 0.f;
        for (int k = 0; k < D; ++k) { const float x = dbf(xr[k]); g += x * dbf(wg[k]); u += x * dbf(wu[k]); }
        const float want = g * dsig(g) * u; dmax(slot, (dbf(F.Hb()[(size_t)m * FF + hc]) - want) / (fabsf(want) + 0.05f));
    }
}
__constant__ float DBG_TOL[DBG_NST] = {1e-6f, 1e-6f, 1e-4f, 1e-5f, 0.f, 5e-3f, 3e-2f, 4e-2f, 4e-2f, 6e-2f, 6e-2f, 5e-3f, 3e-2f, 5e-3f};
__global__ void dbg_emit(Args args) {
    if (threadIdx.x != 0) return;
    const unsigned* DB = (const unsigned*)(args.ws + WS_DBG);
    for (int s = 0; s < DBG_NST; ++s) {
        const float e = __builtin_bit_cast(float, DB[s]);
        if (!(e <= DBG_TOL[s])) {
            float mant = 9.5f; if (e == e) { float q = -10.0f * log10f(fmaxf(e, 1e-8f)); q = fminf(fmaxf(q, 0.f), 80.f); mant = 1.0f + floorf(q + 0.5f) / 10.0f; }
            float c = mant * 1e4f; for (int i = 0; i < s; ++i) c *= 10.0f;
            args.out[0] = c; return;
        }
    }
}
#define DBG_LAUNCH() do { (void)hipMemsetAsync((char*)d_ws + WS_DBG, 0, 4096, stream); hipLaunchKernelGGL(dbg_check, dim3(DBG_NST * DBG_NS), dim3(1024), 0, stream, a); hipLaunchKernelGGL(dbg_emit, dim3(1), dim3(64), 0, stream, a); } while (0)
#else
#define DBG_LAUNCH() do { } while (0)
#endif
extern "C" void kernel_launch(void* const* d_in, const int* in_sizes, int n_in, void* d_out, int out_size, void* d_ws, size_t ws_size, hipStream_t stream) {
    static int grid = 0;
    if (grid == 0) {
        if (n_in != 21 || (size_t)out_size != O_END || ws_size < WS_END) { fprintf(stderr, "kernel_launch: unexpected sizes n_in %d out %d ws %zu\n", n_in, out_size, ws_size); grid = -1; return; }
        int dev = 0, cus = 0, per_cu = 0;
        if (hipGetDevice(&dev) != hipSuccess || hipDeviceGetAttribute(&cus, hipDeviceAttributeMultiprocessorCount, dev) != hipSuccess) { grid = -1; return; }
        if (hipFuncSetAttribute((const void*)fwd_kernel, hipFuncAttributeMaxDynamicSharedMemorySize, LDS_BYTES) != hipSuccess) { fprintf(stderr, "kernel_launch: hipFuncSetAttribute failed\n"); grid = -1; return; }
        if (hipOccupancyMaxActiveBlocksPerMultiprocessor(&per_cu, (const void*)fwd_kernel, NWAVES * 64, LDS_BYTES) != hipSuccess || per_cu < 1) { fprintf(stderr, "kernel_launch: occupancy query says %d\n", per_cu); }
        (void)hipGetLastError();
        grid = cus;
    }
    if (grid < 0) return;
    if (hipMemsetAsync((char*)d_ws + WS_CTL, 0, CTL_ZERO_BYTES, stream) != hipSuccess) return;
    Args a{};
    for (int i = 0; i < 21; ++i) a.in[i] = (const float*)d_in[i];
    a.out = (float*)d_out; a.ws = (unsigned char*)d_ws;
    hipLaunchKernelGGL(fwd_kernel, dim3(grid), dim3(NWAVES * 64), LDS_BYTES, stream, a);
    DBG_LAUNCH();
}
```

```cpp
#ifndef DBG
#define DBG 0
#endif
#ifndef REPMASK
#define REPMASK 0
#endif
#ifndef PHMASK
#define PHMASK 0xFFFF
#endif
#include <hip/hip_runtime.h>
#include <cstdio>
#include <cstdint>
namespace pg8 {
#define PG8_LAS __attribute__((address_space(3)))
typedef unsigned short bf16_t;
typedef short bf16x8 __attribute__((ext_vector_type(8)));
typedef float f32x4 __attribute__((ext_vector_type(4)));
typedef unsigned u32x4 __attribute__((ext_vector_type(4)));
constexpr int BM = 256, BK = 64, HALF = 128, HTB = HALF * BK * 2  , STAGE_BYTES = 8 * HTB, NXCD = 8, WGM = 8;

__host__ __device__ __forceinline__ int lds_byte(int r, int c) { const int st = (r >> 4) * 2 + (c >> 5), rr = r & 15, cc = c & 31, ob = rr * 64 + cc * 2; return st * 1024 + (ob ^ (((ob >> 9) & 1) << 5)); }
__host__ __device__ __forceinline__ void stage_rc(int b, int& R, int& C) { const int st = b / 1024, sb = b % 1024, swz = sb ^ (((sb >> 9) & 1) << 5); R = (st >> 1) * 16 + swz / 64; C = (st & 1) * 32 + (swz % 64) / 2; }
__host__ __device__ __forceinline__ int perm32(int rho) { const int n = rho >> 4, i = rho & 15; return 8 * (i >> 2) + 4 * n + (i & 3); }

struct Unit { int pm, pn; };
struct Gemm { const bf16_t* A; const bf16_t* Bt; int M, N, K; };

struct StaticOrder {
    int nM, nN, nwg, G, c;
    __host__ __device__ void init(int M, int N, int G_, int c_) { nM = M / BM; nN = N / BM; nwg = nM * nN; G = G_; c = c_; }
    __host__ __device__ bool next(int i, Unit& u) const {
        const long L = (long)i * G + c; if (L >= nwg) return false;
        int wgid = (int)L; { const int q = nwg / NXCD, r = nwg % NXCD, xcd = wgid % NXCD, off = wgid / NXCD; wgid = (xcd < r ? xcd * (q + 1) : r * (q + 1) + (xcd - r) * q) + off; }
        const int nig = WGM * nN, gid = wgid / nig, fm = gid * WGM, gsz = (nM - fm) < WGM ? (nM - fm) : WGM;
        u.pm = fm + ((wgid % nig) % gsz); u.pn = (wgid % nig) / gsz; return true;
    }
    __device__ __forceinline__ void a_ready(const Unit&) const {}
    __device__ __forceinline__ void done(const Unit&) const {}
};

__device__ __forceinline__ void copy_piece(const f32x4* src, f32x4* dst, int n4, int tid) {
    constexpr int BT = 16, STEP = 512 * BT;
    asm volatile("" : "+v"(tid));
    f32x4 a[BT], b[BT];
#pragma unroll
    for (int j = 0; j < BT; ++j) if (tid + 512 * j < n4) a[j] = __builtin_nontemporal_load(src + tid + 512 * j);
    for (int i = tid; i < n4; i += 2 * STEP) {
#pragma unroll
        for (int j = 0; j < BT; ++j) if (i + STEP + 512 * j < n4) b[j] = __builtin_nontemporal_load(src + i + STEP + 512 * j);
#pragma unroll
        for (int j = 0; j < BT; ++j) if (i + 512 * j < n4) __builtin_nontemporal_store(a[j], dst + i + 512 * j);
#pragma unroll
        for (int j = 0; j < BT; ++j) if (i + 2 * STEP + 512 * j < n4) a[j] = __builtin_nontemporal_load(src + i + 2 * STEP + 512 * j);
#pragma unroll
        for (int j = 0; j < BT; ++j) if (i + STEP + 512 * j < n4) __builtin_nontemporal_store(b[j], dst + i + STEP + 512 * j);
    }
}
struct CopyOrder : StaticOrder {
    const f32x4* src; f32x4* dst; int n4, slot, tid; mutable int cnt;
    __device__ __forceinline__ void done(const Unit&) const { if (cnt++ == slot) copy_piece(src, dst, n4, tid); }
};

__device__ __forceinline__ unsigned cvt_pk_bf16(float lo, float hi) { unsigned r; asm volatile("v_cvt_pk_bf16_f32 %0, %1, %2" : "=v"(r) : "v"(lo), "v"(hi)); return r; }
typedef float f32x2 __attribute__((ext_vector_type(2)));
typedef unsigned u32x2 __attribute__((ext_vector_type(2)));
__device__ __forceinline__ float fsig(float x) { return __builtin_amdgcn_rcpf(1.0f + __expf(-x)); }
__device__ __forceinline__ float fsilu(float x) { return x * fsig(x); }

struct EpiSwiGLU {
    static constexpr bool PERM = true, AFTER_DRAIN = false;
    bf16_t* H; int ldh;
    __device__ __forceinline__ void operator()(const f32x4 (&acc)[2][2][4][2], const Unit& u, int wr, int wc, int fr, int fq) const {
        const int row0 = u.pm * BM + wr * 64 + fr, col0 = u.pn * HALF + wc * 32 + 8 * fq;
#pragma unroll
        for (int ai = 0; ai < 2; ++ai)
#pragma unroll
            for (int m = 0; m < 4; ++m) {
                bf16_t* p = H + (size_t)(row0 + ai * HALF + m * 16) * ldh + col0;
                const f32x4 g0 = acc[ai][0][m][0], g1 = acc[ai][0][m][1], u0 = acc[ai][1][m][0], u1 = acc[ai][1][m][1];
                float h[8];
#pragma unroll
                for (int i = 0; i < 4; ++i) { h[i] = fsilu(g0[i]) * u0[i]; h[4 + i] = fsilu(g1[i]) * u1[i]; }
                u32x4 w; w.x = cvt_pk_bf16(h[0], h[1]); w.y = cvt_pk_bf16(h[2], h[3]); w.z = cvt_pk_bf16(h[4], h[5]); w.w = cvt_pk_bf16(h[6], h[7]);
                *(u32x4*)p = w;
            }
    }
};

struct EpiResid {
    static constexpr bool PERM = false, AFTER_DRAIN = false;
    const float* resP; const float* resS; float* out; float alpha, scale;
    __device__ __forceinline__ void operator()(const f32x4 (&acc)[2][2][4][2], const Unit& u, int wr, int wc, int fr, int fq) const {
        const int row0 = u.pm * BM + wr * 64 + fr, col0 = u.pn * BM + wc * 32 + 4 * fq;
#pragma unroll
        for (int ai = 0; ai < 2; ++ai)
#pragma unroll
            for (int m = 0; m < 4; ++m) {
                const int row = row0 + ai * HALF + m * 16;
                const float* rb = (row < 16384) ? resP + (size_t)row * 1024 : resS + (size_t)(row - 16384) * 1024;
                float* ob = out + (size_t)row * 1024;
#pragma unroll
                for (int bj = 0; bj < 2; ++bj)
#pragma unroll
                    for (int n = 0; n < 2; ++n) { const int col = col0 + bj * HALF + n * 16;
                        const f32x4 r = *(const f32x4*)(rb + col); *(f32x4*)(ob + col) = r * alpha + acc[ai][bj][m][n] * scale; }
            }
    }
};

struct EpiWin {
    static constexpr bool PERM = false, AFTER_DRAIN = false;
    bf16_t *Qb, *Kb, *Vb; float *HQ, *LOGF, *KH, *HI, *HG; const float *COS, *SIN, *LB;
    float *okp, *ovp, *oks, *ovs;
    __device__ __forceinline__ float* kvdst(float* op, float* os, int row) const {
        if (row < 16384) { const int t = row & 4095, b = row >> 12; return (t >= 2048) ? op + (size_t)(b * 2048 + (t - 2048)) * 512 : (float*)nullptr; }
        const int r = row - 16384; return os + (size_t)((r >> 2) * 2048 + 2044 + (r & 3)) * 512;
    }
    __device__ __forceinline__ void operator()(const f32x4 (&acc)[2][2][4][2], const Unit& u, int wr, int wc, int fr, int fq) const {
        const int typ = u.pn >> 1, cbase = (u.pn & 1) * 256;
        const int row0 = u.pm * BM + wr * 64 + fr;
        if (typ <= 1) {
            bf16_t* dstb = typ == 0 ? Qb : Kb;
            const int e0 = 16 * (wc & 1) + 4 * fq;
#pragma unroll
            for (int ai = 0; ai < 2; ++ai)
#pragma unroll
                for (int m = 0; m < 4; ++m) {
                    const int row = row0 + ai * HALF + m * 16;
                    const int pi = (row < 16384) ? (row & 4095) : 4096 + ((row - 16384) & 3);
                    const f32x4 cs = *(const f32x4*)(COS + pi * 32 + e0), sn = *(const f32x4*)(SIN + pi * 32 + e0);
                    float* fo = (typ == 1) ? kvdst(okp, oks, row) : (float*)nullptr;
#pragma unroll
                    for (int bj = 0; bj < 2; ++bj) {
                        const int hh = (u.pn & 1) * 4 + 2 * bj + (wc >> 1);
                        const f32x4 x1 = acc[ai][bj][m][0], x2 = acc[ai][bj][m][1];
                        const f32x4 o1 = x1 * cs - x2 * sn, o2 = x2 * cs + x1 * sn;
                        bf16_t* pb = dstb + (size_t)row * 512 + hh * 64 + e0;
                        u32x2 w1, w2; w1.x = cvt_pk_bf16(o1[0], o1[1]); w1.y = cvt_pk_bf16(o1[2], o1[3]); w2.x = cvt_pk_bf16(o2[0], o2[1]); w2.y = cvt_pk_bf16(o2[2], o2[3]);
                        *(u32x2*)pb = w1; *(u32x2*)(pb + 32) = w2;
                        if (fo) { *(f32x4*)(fo + hh * 64 + e0) = o1; *(f32x4*)(fo + hh * 64 + e0 + 32) = o2; }
                    }
                }
        } else {
#pragma unroll
            for (int ai = 0; ai < 2; ++ai)
#pragma unroll
                for (int m = 0; m < 4; ++m) {
                    const int row = row0 + ai * HALF + m * 16;
                    float* fo = (typ == 2) ? kvdst(ovp, ovs, row) : (float*)nullptr;
#pragma unroll
                    for (int bj = 0; bj < 2; ++bj)
#pragma unroll
                        for (int n = 0; n < 2; ++n) {
                            const int col = cbase + bj * HALF + wc * 32 + n * 16 + 4 * fq;
                            const f32x4 z = acc[ai][bj][m][n];
                            const size_t off = (size_t)row * 512 + col;
                            if (typ == 2) {
                                u32x2 w; w.x = cvt_pk_bf16(z[0], z[1]); w.y = cvt_pk_bf16(z[2], z[3]); *(u32x2*)(Vb + off) = w;
                                if (fo) *(f32x4*)(fo + col) = z;
                            } else if (typ == 3) {
                                f32x4 o; for (int i = 0; i < 4; ++i) o[i] = fsilu(z[i]); *(f32x4*)(HQ + off) = o;
                            } else if (typ == 4) {
                                const f32x4 lb = *(const f32x4*)(LB + col); f32x4 lf, kh;
                                for (int i = 0; i < 4; ++i) { const float sg = fsig(z[i]), sm = fsig(-z[i]); lf[i] = __logf(lb[i] + (1.0f - lb[i]) * sg); kh[i] = (1.0f - lb[i]) * sm; }
                                *(f32x4*)(LOGF + off) = lf; *(f32x4*)(KH + off) = kh;
                            } else if (typ == 5) {
                                *(f32x4*)(HI + off) = z;
                            } else {
                                f32x4 o; for (int i = 0; i < 4; ++i) o[i] = fsilu(z[i]); *(f32x4*)(HG + off) = o;
                            }
                        }
                }
        }
    }
};

template <class Epi, class Sched, bool ALIGN_EPI = false, bool SP2 = false>
__device__ __forceinline__ void gemm_phase(PG8_LAS unsigned char* lds, const Gemm g, const Sched& S, const Epi& E, int tid_in) {
    int tid_o = tid_in; asm volatile("" : "+v"(tid_o));
    const int tid = tid_o, wid = __builtin_amdgcn_readfirstlane(tid >> 6), lane = tid & 63, wr = wid >> 2, wc = wid & 3, fr = lane & 15, fq = lane >> 4;
    const int K = g.K, nt = K / BK;
    unsigned voffA[2], voffB[2];
#pragma unroll
    for (int i = 0; i < 2; ++i) { int R, C; stage_rc(tid * 16 + i * 8192, R, C); const int Rb = Epi::PERM ? ((R & ~31) + perm32(R & 31)) : R;
        voffA[i] = (unsigned)(R * K + C) * 2u; voffB[i] = (unsigned)(Rb * K + C) * 2u; }
    const size_t kstep = (size_t)(BK * 2);
    const size_t hstep = (size_t)HALF * K * 2;
    const size_t tstep = 2 * hstep;
    const unsigned ldsw = (unsigned)wid * 1024u;
    const int aoff = lds_byte(wr * 64 + fr, fq * 8), boff = lds_byte(wc * 32 + fr, fq * 8);
#define PG8_SA(b, h) (((b) * 2 + (h)) * HTB)
#define PG8_SB(b, h) ((4 + (b) * 2 + (h)) * HTB)
#define PG8_STAGE(bufoff, gbase, voff) do { _Pragma("unroll") for (int _i = 0; _i < 2; ++_i) \
        __builtin_amdgcn_global_load_lds((const unsigned*)((const char*)(gbase) + (voff)[_i]), (PG8_LAS unsigned*)(lds + (bufoff) + ldsw + _i * 8192), 16, 0, 0); } while (0)
#define PG8_LDA(dst, b, h) do { _Pragma("unroll") for (int m = 0; m < 4; ++m) _Pragma("unroll") for (int k = 0; k < 2; ++k) dst[m][k] = *(const PG8_LAS bf16x8*)(lds + PG8_SA(b, h) + aoff + m * 2048 + k * 1024); } while (0)
#define PG8_LDB(dst, b, h) do { _Pragma("unroll") for (int n = 0; n < 2; ++n) _Pragma("unroll") for (int k = 0; k < 2; ++k) dst[n][k] = *(const PG8_LAS bf16x8*)(lds + PG8_SB(b, h) + boff + n * 2048 + k * 1024); } while (0)
#define PG8_MMA(ai, bj, At, Bt) do { __builtin_amdgcn_s_setprio(1); _Pragma("unroll") for (int m = 0; m < 4; ++m) _Pragma("unroll") for (int n = 0; n < 2; ++n) _Pragma("unroll") for (int k = 0; k < 2; ++k) \
        acc[ai][bj][m][n] = __builtin_amdgcn_mfma_f32_16x16x32_bf16(Bt[n][k], At[m][k], acc[ai][bj][m][n], 0, 0, 0); __builtin_amdgcn_s_setprio(0); } while (0)
#define PG8_WAIT_V(n) asm volatile("s_waitcnt vmcnt(" #n ")" ::: "memory")
#define PG8_WAIT_L(n) asm volatile("s_waitcnt lgkmcnt(" #n ")" ::: "memory")
#define PG8_BAR __builtin_amdgcn_s_barrier()
#define PG8_SCHED __builtin_amdgcn_sched_barrier(0)
    Unit cur, nxt; int ui = 0;
    if (!S.next(0, cur)) return;
    f32x4 acc[2][2][4][2];
#pragma unroll
    for (int a = 0; a < 2; ++a)
#pragma unroll
        for (int b = 0; b < 2; ++b)
#pragma unroll
            for (int m = 0; m < 4; ++m)
#pragma unroll
                for (int n = 0; n < 2; ++n) acc[a][b][m][n] = (f32x4){0.f, 0.f, 0.f, 0.f};
    bf16x8 At[4][2], B0[2][2], B1[2][2];
    const char* cA = (const char*)g.A + (size_t)cur.pm * tstep; const char* cB = (const char*)g.Bt + (size_t)cur.pn * tstep;
    S.a_ready(cur);
    if constexpr (SP2) {
        PG8_STAGE(PG8_SB(0, 0), cB, voffB); PG8_STAGE(PG8_SB(0, 1), cB + hstep, voffB); PG8_STAGE(PG8_SA(0, 0), cA, voffA); PG8_STAGE(PG8_SA(0, 1), cA + hstep, voffA);
        if (wr == 1) PG8_BAR;
        PG8_WAIT_V(2); PG8_BAR;
        PG8_STAGE(PG8_SB(1, 0), cB + kstep, voffB); PG8_STAGE(PG8_SA(1, 0), cA + kstep, voffA); PG8_STAGE(PG8_SB(1, 1), cB + hstep + kstep, voffB);
        PG8_WAIT_V(6); PG8_BAR;
    } else {
        PG8_STAGE(PG8_SB(0, 0), cB, voffB); PG8_STAGE(PG8_SA(0, 0), cA, voffA); PG8_STAGE(PG8_SB(0, 1), cB + hstep, voffB); PG8_STAGE(PG8_SA(0, 1), cA + hstep, voffA);
        if (wr == 1) PG8_BAR;
        PG8_WAIT_V(4); PG8_BAR;
        PG8_STAGE(PG8_SB(1, 0), cB + kstep, voffB); PG8_STAGE(PG8_SA(1, 0), cA + kstep, voffA); PG8_STAGE(PG8_SB(1, 1), cB + hstep + kstep, voffB);
        PG8_WAIT_V(6); PG8_BAR;
    }
    for (;;) {
        const bool has_next = S.next(ui + 1, nxt);
        const char* nA = has_next ? (const char*)g.A + (size_t)nxt.pm * tstep : cA; const char* nB = has_next ? (const char*)g.Bt + (size_t)nxt.pn * tstep : cB;
        for (int t = 0; t < nt; t += 2) {
            const bool last = (t == nt - 2);
            const char* a1 = cA + (size_t)(t + 1) * kstep;
            const char* a2 = last ? nA : cA + (size_t)(t + 2) * kstep; const char* b2 = last ? nB : cB + (size_t)(t + 2) * kstep;
            const char* a3 = a2 + kstep; const char* b3 = b2 + kstep;
            if (last && has_next) S.a_ready(nxt);
            if constexpr (SP2) {
            PG8_LDB(B0, 0, 0); PG8_LDB(B1, 0, 1); PG8_SCHED; PG8_LDA(At, 0, 0); PG8_STAGE(PG8_SA(1, 1), a1 + hstep, voffA);
            PG8_WAIT_V(8); PG8_WAIT_L(0); PG8_BAR; PG8_MMA(0, 0, At, B0); PG8_MMA(0, 1, At, B1); PG8_BAR; PG8_SCHED;
            PG8_LDA(At, 0, 1); PG8_STAGE(PG8_SB(0, 0), b2, voffB); PG8_STAGE(PG8_SB(0, 1), b2 + hstep, voffB); PG8_STAGE(PG8_SA(0, 0), a2, voffA);
            PG8_WAIT_V(8); PG8_WAIT_L(0); PG8_BAR; PG8_MMA(1, 0, At, B0); PG8_MMA(1, 1, At, B1); PG8_BAR; PG8_SCHED;
            PG8_LDB(B0, 1, 0); PG8_LDB(B1, 1, 1); PG8_SCHED; PG8_LDA(At, 1, 0); PG8_STAGE(PG8_SA(0, 1), a2 + hstep, voffA);
            PG8_WAIT_V(8); PG8_WAIT_L(0); PG8_BAR; PG8_MMA(0, 0, At, B0); PG8_MMA(0, 1, At, B1); PG8_BAR; PG8_SCHED;
            PG8_LDA(At, 1, 1); PG8_STAGE(PG8_SB(1, 0), b3, voffB); PG8_STAGE(PG8_SB(1, 1), b3 + hstep, voffB); PG8_STAGE(PG8_SA(1, 0), a3, voffA);
            PG8_WAIT_V(8); PG8_WAIT_L(0); PG8_BAR; PG8_MMA(1, 0, At, B0); PG8_MMA(1, 1, At, B1); PG8_BAR; PG8_SCHED;
            } else {
            PG8_LDB(B0, 0, 0); PG8_SCHED; PG8_LDA(At, 0, 0); PG8_STAGE(PG8_SA(1, 1), a1 + hstep, voffA);
            PG8_WAIT_L(8); PG8_BAR; PG8_WAIT_L(0); PG8_MMA(0, 0, At, B0); PG8_BAR; PG8_SCHED;
            PG8_LDB(B1, 0, 1); PG8_STAGE(PG8_SB(0, 0), b2, voffB);
            PG8_BAR; PG8_WAIT_L(0); PG8_MMA(0, 1, At, B1); PG8_BAR;
            PG8_LDA(At, 0, 1); PG8_STAGE(PG8_SA(0, 0), a2, voffA);
            PG8_BAR; PG8_WAIT_L(0); PG8_MMA(1, 0, At, B0); PG8_BAR; PG8_SCHED;
            PG8_STAGE(PG8_SB(0, 1), b2 + hstep, voffB);
            PG8_WAIT_V(6); PG8_BAR; PG8_MMA(1, 1, At, B1); PG8_BAR;
            PG8_LDB(B0, 1, 0); PG8_SCHED; PG8_LDA(At, 1, 0); PG8_STAGE(PG8_SA(0, 1), a2 + hstep, voffA);
            PG8_WAIT_L(8); PG8_BAR; PG8_WAIT_L(0); PG8_MMA(0, 0, At, B0); PG8_BAR; PG8_SCHED;
            PG8_LDB(B1, 1, 1); PG8_STAGE(PG8_SB(1, 0), b3, voffB);
            PG8_BAR; PG8_WAIT_L(0); PG8_MMA(0, 1, At, B1); PG8_BAR;
            PG8_LDA(At, 1, 1); PG8_STAGE(PG8_SA(1, 0), a3, voffA);
            PG8_BAR; PG8_WAIT_L(0); PG8_MMA(1, 0, At, B0); PG8_BAR; PG8_SCHED;
            PG8_STAGE(PG8_SB(1, 1), b3 + hstep, voffB);
            PG8_WAIT_V(6); PG8_BAR; PG8_MMA(1, 1, At, B1); PG8_BAR;
            }
        }
        if constexpr (ALIGN_EPI) { if (wr == 0) PG8_BAR; }
        if constexpr (!Epi::AFTER_DRAIN) { E(acc, cur, wr, wc, fr, fq); S.done(cur); }
        if (!has_next) break;
#pragma unroll
        for (int a = 0; a < 2; ++a)
#pragma unroll
            for (int b = 0; b < 2; ++b)
#pragma unroll
                for (int m = 0; m < 4; ++m)
#pragma unroll
                    for (int n = 0; n < 2; ++n) acc[a][b][m][n] = (f32x4){0.f, 0.f, 0.f, 0.f};
        cur = nxt; cA = nA; cB = nB; ++ui;
        if constexpr (ALIGN_EPI) { if (wr == 1) PG8_BAR; }
    }
    PG8_WAIT_V(0);
    if constexpr (!ALIGN_EPI) { if (wr == 0) PG8_BAR; }
    PG8_BAR;
    if constexpr (Epi::AFTER_DRAIN) { E.fused(acc, cur, wr, wc, fr, fq, lds, wid, lane); S.done(cur); }
#undef PG8_SA
#undef PG8_SB
#undef PG8_STAGE
#undef PG8_LDA
#undef PG8_LDB
#undef PG8_MMA
#undef PG8_WAIT_V
#undef PG8_WAIT_L
#undef PG8_BAR
#undef PG8_SCHED
}
}
#define GAS __attribute__((address_space(1)))
#define LAS __attribute__((address_space(3)))
typedef unsigned short bf16;
typedef unsigned v4u __attribute__((ext_vector_type(4)));
typedef float f32x4 __attribute__((ext_vector_type(4)));
typedef short bf16x8 __attribute__((ext_vector_type(8)));
typedef GAS unsigned gu32;
typedef GAS unsigned long long gu64;
#define RLX_AGENT __ATOMIC_RELAXED, __HIP_MEMORY_SCOPE_AGENT
#define LDS_WAIT() asm volatile("s_waitcnt lgkmcnt(0)" ::: "memory")
#define VM_WAIT() asm volatile("s_waitcnt vmcnt(0)" ::: "memory")
__device__ __forceinline__ unsigned long long rt() { return __builtin_amdgcn_s_memrealtime(); }
__device__ __forceinline__ unsigned f2bf(float f) { unsigned u = __builtin_bit_cast(unsigned, f); return (u + 0x7fffu + ((u >> 16) & 1u)) >> 16; }
__device__ __forceinline__ unsigned pk2(float lo, float hi) { return f2bf(lo) | (f2bf(hi) << 16); }

#define XB_TMO      128
#define XB_XCNT(j)  (256  + 64 * (j))
#define XB_XSUB(j)  (1280 + 64 * (j))
#define XB_XGEN(j)  (2304 + 64 * (j))
#define XB_TOP      3328
#define XB_TOPGEN   3392
#define XCD_BAR_WORDS 3456
#define XB_SPIN_CAP (1u << 18)

__device__ __forceinline__ unsigned xb_ld(unsigned* p)              { return __hip_atomic_load(p, __ATOMIC_RELAXED, __HIP_MEMORY_SCOPE_AGENT); }
__device__ __forceinline__ unsigned xb_add(unsigned* p, unsigned v) { return __hip_atomic_fetch_add(p, v, __ATOMIC_RELAXED, __HIP_MEMORY_SCOPE_AGENT); }
__device__ __forceinline__ unsigned xb_xcc_id() { return (unsigned)__builtin_amdgcn_s_getreg((3 << 11) | 20) & 0xFu; }
#define XB_SPIN(cond, bar) do { unsigned _sp = 0; while (cond) { __builtin_amdgcn_s_sleep(1); \
    if ((++_sp & 255u) == 0u) { if (xb_ld(&(bar)[XB_TMO])) break; if (_sp > XB_SPIN_CAP) { atomicAdd(&(bar)[XB_TMO], 1u); break; } } } } while (0)

struct XcdBarrier {
    unsigned* bar; unsigned x;
    volatile LAS unsigned* st;
};

__device__ __forceinline__ XcdBarrier xcd_barrier_post(unsigned* bar, volatile LAS unsigned* st) {
    XcdBarrier b; b.bar = bar; b.x = xb_xcc_id(); b.st = st;
    if (threadIdx.x == 0) (void)xb_add(&bar[XB_XCNT(b.x)], 1u);
    return b;
}
__device__ __forceinline__ void xcd_barrier_complete(unsigned* bar, unsigned x, unsigned& nloc, unsigned& nx) {
    const unsigned G = gridDim.x * gridDim.y * gridDim.z;
    unsigned sum, cnt, mine, sp = 0u;
    for (;;) {
        sum = 0u; cnt = 0u; mine = 0u;
#pragma unroll
        for (unsigned j = 0; j < 16; ++j) { const unsigned c = xb_ld(&bar[XB_XCNT(j)]); sum += c; cnt += (c > 0u) ? 1u : 0u; mine = (j == x) ? c : mine; }
        if (sum == G) break;
        __builtin_amdgcn_s_sleep(1);
        if ((++sp & 255u) == 0u) { if (xb_ld(&bar[XB_TMO])) break; if (sp > XB_SPIN_CAP) { atomicAdd(&bar[XB_TMO], 1u); break; } }
    }
    nloc = mine > 0u ? mine : 1u; nx = cnt > 0u ? cnt : 1u;
}

__device__ __forceinline__ void xcd_barrier(const XcdBarrier& b) {
    asm volatile("s_waitcnt vmcnt(0)" ::: "memory");
    __syncthreads();
    if (threadIdx.x == 0) {
        unsigned* bar = b.bar;
        __builtin_amdgcn_s_waitcnt(0);
        unsigned nloc = b.st[0], nx = b.st[1];
        if (nloc == 0u) { xcd_barrier_complete(bar, b.x, nloc, nx); b.st[0] = nloc; b.st[1] = nx; }
        const unsigned old = xb_add(&bar[XB_XSUB(b.x)], 1u);
        const unsigned gen = old / nloc;
        if (old + 1u == (gen + 1u) * nloc) {
            __builtin_amdgcn_fence(__ATOMIC_RELEASE, "agent");
            asm volatile("s_waitcnt vmcnt(0)" ::: "memory");
            const unsigned og = xb_add(&bar[XB_TOP], 1u);
            const unsigned tg = og / nx;
            if (og + 1u == (tg + 1u) * nx) xb_add(&bar[XB_TOPGEN], 1u);
            else XB_SPIN(xb_ld(&bar[XB_TOPGEN]) == tg, bar);
            __builtin_amdgcn_fence(__ATOMIC_ACQUIRE, "agent");
            xb_add(&bar[XB_XGEN(b.x)], 1u);
            asm volatile("s_waitcnt vmcnt(0)" ::: "memory");
        } else {
            XB_SPIN(xb_ld(&bar[XB_XGEN(b.x)]) == gen, bar);
            __builtin_amdgcn_fence(__ATOMIC_ACQUIRE, "agent");
            asm volatile("s_waitcnt vmcnt(0)" ::: "memory");
        }
    }
    __syncthreads();
}
constexpr int NWAVES = 8;
constexpr int D = 1024, MP = 16384, MS = 512, M = MP + MS, FF = 2816, NGU = 2 * FF, NIN = 3584, SEQ = 4096;
constexpr float LN_EPS = 1e-5f;
constexpr float DN_ALPHA = 1.189207115002721f;
constexpr size_t MiB = 1u << 20;
constexpr size_t WS_CTL = 0, CTL_ZERO_BYTES = 1 * MiB;
constexpr size_t WS_COS = 1 * MiB, WS_SIN = 1 * MiB + 640 * 1024, WS_LB = 1 * MiB + 1280 * 1024;
constexpr size_t WS_W1GU = 4 * MiB, WS_W1D = 15 * MiB, WS_WIN = 21 * MiB, WS_WOUT = 28 * MiB, WS_W2GU = 30 * MiB, WS_W2D = 41 * MiB;
constexpr size_t WS_XB = 48 * MiB, WS_X1B = 82 * MiB, WS_X2B = 116 * MiB, WS_H = 150 * MiB, WS_YPRE = 242 * MiB, WS_X1 = 308 * MiB, WS_X2 = 374 * MiB;
constexpr size_t WS_QB = 440 * MiB, WS_KB = 457 * MiB, WS_VB = 474 * MiB, WS_HQ = 491 * MiB, WS_LOGF = 524 * MiB, WS_KH = 557 * MiB, WS_HI = 590 * MiB, WS_HG = 623 * MiB;
constexpr size_t WS_CAT = 656 * MiB, WS_OPART = 689 * MiB, WS_LSE = 785 * MiB, WS_USEG = 787 * MiB, WS_DSEG = 803 * MiB, WS_DBG = 804 * MiB, WS_END = 806 * MiB;
static_assert(WS_W1GU + (size_t)NGU * D * 2 <= WS_W1D && WS_W1D + (size_t)D * FF * 2 <= WS_WIN && WS_WIN + (size_t)NIN * D * 2 <= WS_WOUT && WS_WOUT + (size_t)D * D * 2 <= WS_W2GU, "ws map (weights)");
static_assert(WS_XB + (size_t)M * D * 2 <= WS_X1B && WS_H + (size_t)M * FF * 2 <= WS_YPRE && WS_YPRE + (size_t)M * D * 4 <= WS_X1 && WS_X2 + (size_t)M * D * 4 <= WS_QB, "ws map (activations)");
static_assert(WS_QB + (size_t)M * 512 * 2 <= WS_KB && WS_HQ + (size_t)M * 512 * 4 <= WS_LOGF && WS_OPART + (size_t)3 * MP * 512 * 4 <= WS_LSE && WS_USEG + (size_t)256 * 65536 <= WS_DSEG, "ws map (mixer)");
constexpr int CW_BAR = 4096;
constexpr size_t O_YP = 0, O_YS = 16777216, O_KP = O_YS + 524288, O_VP = O_KP + 4194304, O_SP = O_VP + 4194304, O_KS = O_SP + 262144, O_VS = O_KS + 134217728, O_SS = O_VS + 134217728, O_END = O_SS + 8388608;
constexpr int RING_OFF = 0, RING_BYTES = 131072, LDSCTL_OFF = RING_BYTES, MISC_OFF = LDSCTL_OFF + 320, LDS_BYTES = 147456;

__constant__ float INV_FREQ[32] = {1.000000000e+00f, 7.498942614e-01f, 5.623413324e-01f, 4.216965139e-01f, 3.162277639e-01f, 2.371373773e-01f, 1.778279394e-01f, 1.333521307e-01f, 1.000000015e-01f, 7.498941571e-02f, 5.623413250e-02f, 4.216965288e-02f, 3.162277490e-02f, 2.371373773e-02f, 1.778279431e-02f, 1.333521493e-02f, 9.999999776e-03f, 7.498941850e-03f, 5.623413250e-03f, 4.216964822e-03f, 3.162277630e-03f, 2.371373586e-03f, 1.778279431e-03f, 1.333521446e-03f, 1.000000047e-03f, 7.498942432e-04f, 5.623413017e-04f, 4.216965172e-04f, 3.162277571e-04f, 2.371373703e-04f, 1.778279402e-04f, 1.333521504e-04f};

typedef unsigned u32x2 __attribute__((ext_vector_type(2)));
typedef unsigned short u16;
struct Ctx {
    LAS unsigned char* lds;
    int tid, lane, wave, G, bid;
    const float *xp, *xs, *ck, *cv, *st0, *w1g, *w1u, *w1d, *ln1g, *ln1b, *win, *hlb, *hng, *wout, *ln2g, *ln2b, *w2g, *w2u, *w2d, *ln3g, *ln3b;
    float* out; unsigned char* ws;
    __device__ __forceinline__ bf16* W1gu() const { return (bf16*)(ws + WS_W1GU); }
    __device__ __forceinline__ bf16* W1d() const { return (bf16*)(ws + WS_W1D); }
    __device__ __forceinline__ bf16* Win() const { return (bf16*)(ws + WS_WIN); }
    __device__ __forceinline__ bf16* Wout() const { return (bf16*)(ws + WS_WOUT); }
    __device__ __forceinline__ bf16* W2gu() const { return (bf16*)(ws + WS_W2GU); }
    __device__ __forceinline__ bf16* W2d() const { return (bf16*)(ws + WS_W2D); }
    __device__ __forceinline__ bf16* Xb() const { return (bf16*)(ws + WS_XB); }
    __device__ __forceinline__ bf16* X1b() const { return (bf16*)(ws + WS_X1B); }
    __device__ __forceinline__ bf16* X2b() const { return (bf16*)(ws + WS_X2B); }
    __device__ __forceinline__ bf16* Hb() const { return (bf16*)(ws + WS_H); }
    __device__ __forceinline__ bf16* Qb() const { return (bf16*)(ws + WS_QB); }
    __device__ __forceinline__ bf16* Kb() const { return (bf16*)(ws + WS_KB); }
    __device__ __forceinline__ bf16* Vb() const { return (bf16*)(ws + WS_VB); }
    __device__ __forceinline__ bf16* Cat() const { return (bf16*)(ws + WS_CAT); }
    __device__ __forceinline__ float* Ypre() const { return (float*)(ws + WS_YPRE); }
    __device__ __forceinline__ float* X1() const { return (float*)(ws + WS_X1); }
    __device__ __forceinline__ float* X2() const { return (float*)(ws + WS_X2); }
    __device__ __forceinline__ float* HQ() const { return (float*)(ws + WS_HQ); }
    __device__ __forceinline__ float* LOGF() const { return (float*)(ws + WS_LOGF); }
    __device__ __forceinline__ float* KH() const { return (float*)(ws + WS_KH); }
    __device__ __forceinline__ float* HI() const { return (float*)(ws + WS_HI); }
    __device__ __forceinline__ float* HG() const { return (float*)(ws + WS_HG); }
    __device__ __forceinline__ float* COS() const { return (float*)(ws + WS_COS); }
    __device__ __forceinline__ float* SIN() const { return (float*)(ws + WS_SIN); }
    __device__ __forceinline__ float* LB() const { return (float*)(ws + WS_LB); }
    __device__ __forceinline__ float* Opart() const { return (float*)(ws + WS_OPART); }
    __device__ __forceinline__ float* Lse() const { return (float*)(ws + WS_LSE); }
    __device__ __forceinline__ float* Useg() const { return (float*)(ws + WS_USEG); }
    __device__ __forceinline__ float* Dseg() const { return (float*)(ws + WS_DSEG); }
};
__device__ __forceinline__ float wave_sum(float v) {
#pragma unroll
    for (int o = 1; o < 64; o <<= 1) v += __shfl_xor(v, o);
    return v;
}
template <int CTRL> __device__ __forceinline__ float dppf(float v) { return __builtin_bit_cast(float, __builtin_amdgcn_update_dpp(0, __builtin_bit_cast(int, v), CTRL, 0xf, 0xf, true)); }
__device__ __forceinline__ float row16_sum(float v) { v += dppf<0x128>(v); v += dppf<0x124>(v); v += dppf<0x122>(v); v += dppf<0x121>(v); return v; }
__device__ __forceinline__ float bf2f(unsigned h) { return __builtin_bit_cast(float, h << 16); }

struct RmNat { __device__ __forceinline__ int operator()(int c) const { return c; } };
struct RmGate { __device__ __forceinline__ int operator()(int c) const { return 256 * (c >> 7) + (c & 127); } };
struct RmUp { __device__ __forceinline__ int operator()(int c) const { return 256 * (c >> 7) + 128 + (c & 127); } };
struct RmWin { __device__ __forceinline__ int operator()(int c) const { if (c >= 1024) return c; const int j = c & 63; return (c & ~63) | (j & 15) | (((j >> 4) & 1) << 5) | (((j >> 5) & 1) << 4); } };
template <class RM>
__device__ __forceinline__ void p0_transpose_item(const float* W, int K, int N, bf16* WT, RM rm, LAS float* scr, int item, int lane) {
    const int nblk = N / 32, kb = item / nblk, nb = item % nblk, k0 = 64 * kb, n0 = 32 * nb;
#pragma unroll 8
    for (int i = 0; i < 32; ++i) { const int kk = 2 * i + (lane >> 5); scr[kk * 33 + (lane & 31)] = W[(size_t)(k0 + kk) * N + n0 + (lane & 31)]; }
    LDS_WAIT(); asm volatile("" ::: "memory");
    const int c = lane & 7;
#pragma unroll
    for (int j = 0; j < 4; ++j) { const int n = (lane >> 3) + 8 * j; const LAS float* s = scr + (8 * c) * 33 + n;
        v4u o; o.x = pk2(s[0 * 33], s[1 * 33]); o.y = pk2(s[2 * 33], s[3 * 33]); o.z = pk2(s[4 * 33], s[5 * 33]); o.w = pk2(s[6 * 33], s[7 * 33]);
        *(GAS v4u*)(WT + (size_t)rm(n0 + n) * K + k0 + 8 * c) = o; }
    LDS_WAIT(); asm volatile("" ::: "memory");
}
__device__ __forceinline__ void p0_prologue(const Ctx& F) {
    LAS float* scr = (LAS float*)(F.lds + RING_OFF + F.wave * 16384);
    const int gw = F.bid * NWAVES + F.wave, NGW = F.G * NWAVES;
    constexpr int I_G = (D / 64) * (FF / 32), I_D = (FF / 64) * (D / 32), I_IN = (D / 64) * (NIN / 32), I_O = (D / 64) * (D / 32);
    constexpr int NITEMS = 6 * I_G + I_IN + I_O; static_assert(I_G == I_D, "item counts");
    for (int it = gw; it < NITEMS; it += NGW) {
        int r = it;
        if (r < I_G) { p0_transpose_item(F.w1g, D, FF, F.W1gu(), RmGate(), scr, r, F.lane); continue; } r -= I_G;
        if (r < I_G) { p0_transpose_item(F.w1u, D, FF, F.W1gu(), RmUp(), scr, r, F.lane); continue; } r -= I_G;
        if (r < I_D) { p0_transpose_item(F.w1d, FF, D, F.W1d(), RmNat(), scr, r, F.lane); continue; } r -= I_D;
        if (r < I_G) { p0_transpose_item(F.w2g, D, FF, F.W2gu(), RmGate(), scr, r, F.lane); continue; } r -= I_G;
        if (r < I_G) { p0_transpose_item(F.w2u, D, FF, F.W2gu(), RmUp(), scr, r, F.lane); continue; } r -= I_G;
        if (r < I_D) { p0_transpose_item(F.w2d, FF, D, F.W2d(), RmNat(), scr, r, F.lane); continue; } r -= I_D;
        if (r < I_IN) { p0_transpose_item(F.win, D, NIN, F.Win(), RmWin(), scr, r, F.lane); continue; } r -= I_IN;
        p0_transpose_item(F.wout, D, D, F.Wout(), RmNat(), scr, r, F.lane);
    }
    for (int m = gw; m < M; m += NGW) {
        const float* xr = (m < MP) ? F.xp + (size_t)m * D : F.xs + (size_t)(m - MP) * D;
        const GAS f32x4* xv = (const GAS f32x4*)xr + F.lane; GAS unsigned long long* o8 = (GAS unsigned long long*)(F.Xb() + (size_t)m * D) + F.lane;
#pragma unroll
        for (int j = 0; j < 4; ++j) { const f32x4 v = xv[64 * j]; o8[64 * j] = (unsigned long long)pk2(v.x, v.y) | ((unsigned long long)pk2(v.z, v.w) << 32); }
    }
    for (int idx = F.bid * 512 + F.tid; idx < 4100 * 32; idx += F.G * 512) {
        const int pi = idx >> 5, i = idx & 31; const int pos = pi < 4096 ? pi : 8192 + (pi - 4096);
        const float ang = (float)pos * INV_FREQ[i];
        double rev = (double)ang * 0.15915494309189535; rev -= __builtin_rint(rev);
        const float rf = (float)rev;
        F.COS()[idx] = __builtin_amdgcn_cosf(rf); F.SIN()[idx] = __builtin_amdgcn_sinf(rf);
    }
    if (F.bid == 0) { const int c = F.tid; const float a0 = F.hlb[c], a1 = F.hlb[512 + c]; const float mx = fmaxf(a0, a1); const float e0 = __expf(a0 - mx), e1 = __expf(a1 - mx); F.LB()[c] = e0 / (e0 + e1); }
    if (F.G != 256) {
        constexpr size_t PER_B = (size_t)2044 * 512 / 4;
        const size_t nth = (size_t)F.G * 512;
        for (size_t i = (size_t)F.bid * 512 + F.tid; i < 128 * PER_B; i += nth) {
            const size_t b = i / PER_B, r = i - b * PER_B;
            const f32x4 a = __builtin_nontemporal_load((const f32x4*)(F.ck + b * 1048576 + 2048) + r);
            const f32x4 c = __builtin_nontemporal_load((const f32x4*)(F.cv + b * 1048576 + 2048) + r);
            __builtin_nontemporal_store(a, (f32x4*)(F.out + O_KS + b * 1048576) + r);
            __builtin_nontemporal_store(c, (f32x4*)(F.out + O_VS + b * 1048576) + r);
        }
    }
}
__device__ __forceinline__ void ln_rows(const Ctx& F, const float* pre, const float* gam, const float* bet, float* outf, bf16* outb) {
    const int gw = F.bid * NWAVES + F.wave, NGW = F.G * NWAVES;
    f32x4 gv[4], bv[4];
#pragma unroll
    for (int j = 0; j < 4; ++j) { gv[j] = ((const f32x4*)gam)[F.lane + 64 * j]; bv[j] = ((const f32x4*)bet)[F.lane + 64 * j]; }
    for (int m = gw; m < M; m += NGW) {
        const f32x4* xr = (const f32x4*)(pre + (size_t)m * D) + F.lane;
        f32x4 v[4]; float s = 0.f;
#pragma unroll
        for (int j = 0; j < 4; ++j) { v[j] = xr[64 * j]; s += (v[j].x + v[j].y) + (v[j].z + v[j].w); }
        const float mean = wave_sum(s) * (1.f / D); float s2 = 0.f;
#pragma unroll
        for (int j = 0; j < 4; ++j) { v[j] = v[j] - mean; s2 += (v[j].x * v[j].x + v[j].y * v[j].y) + (v[j].z * v[j].z + v[j].w * v[j].w); }
        const float rstd = 1.f / sqrtf(wave_sum(s2) * (1.f / D) + LN_EPS);
#pragma unroll
        for (int j = 0; j < 4; ++j) { const f32x4 y = v[j] * rstd * gv[j] + bv[j];
            ((f32x4*)(outf + (size_t)m * D))[F.lane + 64 * j] = y;
            if (outb) ((unsigned long long*)(outb + (size_t)m * D))[F.lane + 64 * j] = (unsigned long long)pk2(y.x, y.y) | ((unsigned long long)pk2(y.z, y.w) << 32); }
    }
}
typedef float f32x4v __attribute__((ext_vector_type(4)));
#define MFMA16(a, b, c) __builtin_amdgcn_mfma_f32_16x16x32_bf16((a), (b), (c), 0, 0, 0)
__device__ __forceinline__ bf16x8 pack8(const f32x4 a, const f32x4 b) {
    v4u w; w.x = pk2(a[0], a[1]); w.y = pk2(a[2], a[3]); w.z = pk2(b[0], b[1]); w.w = pk2(b[2], b[3]); return __builtin_bit_cast(bf16x8, w);
}
__device__ __forceinline__ bf16x8 join8(const u32x2 lo, const u32x2 hi) { v4u w; w.x = lo.x; w.y = lo.y; w.z = hi.x; w.w = hi.y; return __builtin_bit_cast(bf16x8, w); }

__device__ __forceinline__ void attn_prompt_unit(const Ctx& F, int u) {
    LAS unsigned char* L = F.lds;
    const int tid = F.tid, lane = F.lane, w = F.wave;
    const int bh = u / 96, rem = u - bh * 96, di = rem >> 5, x = rem & 31;
    const int b = bh >> 3, h = bh & 7, dsh = 2 * di, nbsh = 5 - dsh;
    const int r = x >> nbsh, qb = x & ((1 << nbsh) - 1);
    constexpr int KS_STRIDE = 144, VT_OFF = 256 * 144, VT_STRIDE = 528;
    {
        const int key = tid >> 1, half = tid & 1, isub = 128 * (qb - 1) + key;
        v4u kv[4], vv[4];
        if (isub >= 0) {
            const size_t row = (size_t)b * SEQ + r + ((size_t)isub << dsh);
            const v4u* kp = (const v4u*)(F.Kb() + row * 512 + h * 64 + 32 * half);
            const v4u* vp = (const v4u*)(F.Vb() + row * 512 + h * 64 + 32 * half);
#pragma unroll
            for (int i = 0; i < 4; ++i) { kv[i] = kp[i]; vv[i] = vp[i]; }
        } else {
#pragma unroll
            for (int i = 0; i < 4; ++i) { kv[i] = (v4u){0u, 0u, 0u, 0u}; vv[i] = (v4u){0u, 0u, 0u, 0u}; }
        }
#pragma unroll
        for (int i = 0; i < 4; ++i) *(LAS v4u*)(L + key * KS_STRIDE + (32 * half + 8 * i) * 2) = kv[i];
#pragma unroll
        for (int i = 0; i < 4; ++i)
#pragma unroll
            for (int c = 0; c < 4; ++c) { const unsigned wd = vv[i][c]; const int e = 32 * half + 8 * i + 2 * c;
                *(LAS u16*)(L + VT_OFF + e * VT_STRIDE + key * 2) = (u16)(wd & 0xffffu);
                *(LAS u16*)(L + VT_OFF + (e + 1) * VT_STRIDE + key * 2) = (u16)(wd >> 16); }
    }
    __syncthreads();
    const int q = lane & 15, g = lane >> 4;
    const int iq = 128 * qb + 16 * w + q;
    const size_t qrow = (size_t)b * SEQ + r + ((size_t)iq << dsh);
    const bf16x8 qf0 = *(const bf16x8*)(F.Qb() + qrow * 512 + h * 64 + 8 * g), qf1 = *(const bf16x8*)(F.Qb() + qrow * 512 + h * 64 + 32 + 8 * g);
    f32x4 s[9];
#pragma unroll
    for (int kt = 0; kt < 9; ++kt) {
        const int key = 16 * (w + kt) + q;
        const bf16x8 a0 = *(const LAS bf16x8*)(L + key * KS_STRIDE + (8 * g) * 2), a1 = *(const LAS bf16x8*)(L + key * KS_STRIDE + (32 + 8 * g) * 2);
        f32x4 acc = (f32x4){0.f, 0.f, 0.f, 0.f};
        acc = MFMA16(a0, qf0, acc); acc = MFMA16(a1, qf1, acc); s[kt] = acc;
    }
    float mx = -INFINITY;
#pragma unroll
    for (int kt = 0; kt < 9; ++kt)
#pragma unroll
        for (int rg = 0; rg < 4; ++rg) { const int cc = 16 * kt + 4 * g + rg; const bool ok = (cc >= q) && (cc <= q + 128) && (qb > 0 || 16 * w + cc >= 128);
            const float v = ok ? s[kt][rg] * 0.125f : -INFINITY; s[kt][rg] = v; mx = fmaxf(mx, v); }
    mx = fmaxf(mx, __shfl_xor(mx, 16)); mx = fmaxf(mx, __shfl_xor(mx, 32));
    float lsum = 0.f;
#pragma unroll
    for (int kt = 0; kt < 9; ++kt)
#pragma unroll
        for (int rg = 0; rg < 4; ++rg) { const float p = __expf(s[kt][rg] - mx); s[kt][rg] = p; lsum += p; }
    lsum += __shfl_xor(lsum, 16); lsum += __shfl_xor(lsum, 32);
    f32x4 o[4];
#pragma unroll
    for (int et = 0; et < 4; ++et) o[et] = (f32x4){0.f, 0.f, 0.f, 0.f};
    const f32x4 zero4 = (f32x4){0.f, 0.f, 0.f, 0.f};
#pragma unroll
    for (int p = 0; p < 5; ++p) {
        const bf16x8 pa = pack8(s[2 * p], p < 4 ? s[2 * p + 1] : zero4);
#pragma unroll
        for (int et = 0; et < 4; ++et) {
            const LAS unsigned char* vb = L + VT_OFF + (16 * et + q) * VT_STRIDE + (16 * w + 32 * p + 4 * g) * 2;
            const u32x2 lo = *(const LAS u32x2*)vb; u32x2 hi = (u32x2){0u, 0u}; if (p < 4) hi = *(const LAS u32x2*)(vb + 32);
            o[et] = MFMA16(pa, join8(lo, hi), o[et]);
        }
    }
#pragma unroll
    for (int rg = 0; rg < 4; ++rg) {
        const float lq = __shfl(lsum, 4 * g + rg), mq = __shfl(mx, 4 * g + rg);
        const int iq2 = 128 * qb + 16 * w + 4 * g + rg;
        const size_t row = (size_t)b * SEQ + r + ((size_t)iq2 << dsh);
        const float inv = 1.0f / lq;
        float* op = F.Opart() + ((size_t)di * MP + row) * 512 + h * 64 + q;
#pragma unroll
        for (int et = 0; et < 4; ++et) op[16 * et] = o[et][rg] * inv;
        if (q == 0) F.Lse()[((size_t)di * MP + row) * 8 + h] = mq + __logf(lq);
    }
    __syncthreads();
}
__device__ __forceinline__ void attn_combine_rows(const Ctx& F) {
    const int gw = F.bid * NWAVES + F.wave, NGW = F.G * NWAVES, lane = F.lane, h = lane >> 3;
    for (int m = gw; m < MP; m += NGW) {
        float ls[3], wt[3];
#pragma unroll
        for (int i = 0; i < 3; ++i) ls[i] = F.Lse()[((size_t)i * MP + m) * 8 + h];
        const float mxl = fmaxf(ls[0], fmaxf(ls[1], ls[2])); float den = 0.f;
#pragma unroll
        for (int i = 0; i < 3; ++i) { wt[i] = __expf(ls[i] - mxl); den += wt[i]; }
        const float rden = 1.0f / den;
        f32x4 a0 = (f32x4){0.f, 0.f, 0.f, 0.f}, a1 = a0;
#pragma unroll
        for (int i = 0; i < 3; ++i) { const f32x4* p = (const f32x4*)(F.Opart() + ((size_t)i * MP + m) * 512 + lane * 8); a0 += p[0] * (wt[i] * rden); a1 += p[1] * (wt[i] * rden); }
        v4u o; o.x = pk2(a0[0], a0[1]); o.y = pk2(a0[2], a0[3]); o.z = pk2(a1[0], a1[1]); o.w = pk2(a1[2], a1[3]);
        *(v4u*)(F.Cat() + (size_t)m * 1024 + lane * 8) = o;
    }
}
__device__ __forceinline__ int samp_rho_row(int rho, int rot) { rho += rot; rho = rho >= 900 ? rho - 900 : rho; return rho < 384 ? ((rho >> 2) << 4) + (rho & 3) : 1152 + rho; }
__device__ __forceinline__ const f32x4* samp_rowp(const float* cache, const float* onew, int bd, int r, int hf, int lane) {
    const float* p = r < 2048 ? cache + (size_t)(bd * 2048 + r) * 512 : onew + (size_t)(bd * 2048 + 2044 + (r - 2048)) * 512;
    return (const f32x4*)(p + hf * 256) + lane;
}
__device__ __forceinline__ void attn_sample_unit(const Ctx& F, int u) {
    const int bd = u >> 1, hf = u & 1, tid = F.tid, lane = F.lane, w = F.wave, hl = lane >> 4, li = lane & 15;
    LAS float* SC = (LAS float*)F.lds;
    LAS float* ST = (LAS float*)(F.lds + 25344);
    LAS float* CF = (LAS float*)(F.lds + 25728);
    LAS float* RED = (LAS float*)(F.lds + 32768);
    const float* okn = F.out + O_KS; const float* ovn = F.out + O_VS;
    const int rot = (u * 29) % 900;
    f32x4 qv[4];
#pragma unroll
    for (int s = 0; s < 4; ++s) { const u32x2 qw = *(const u32x2*)(F.Qb() + (size_t)(MP + bd * 4 + s) * 512 + (4 * hf + hl) * 64 + 4 * li);
        qv[s] = (f32x4){bf2f(qw.x & 0xffffu), bf2f(qw.x >> 16), bf2f(qw.y & 0xffffu), bf2f(qw.y >> 16)} * 0.125f; }
    for (int i0 = 0; i0 < 113; i0 += 8) {
        f32x4 kk[8];
#pragma unroll
        for (int j = 0; j < 8; ++j) { const int rho = w + 8 * (i0 + j); kk[j] = __builtin_nontemporal_load(samp_rowp(F.ck, okn, bd, samp_rho_row(rho < 900 ? rho : 899, rot), hf, lane)); }
#pragma unroll
        for (int j = 0; j < 8; ++j) { const int rho = w + 8 * (i0 + j);
            if (rho < 900) { const int r = samp_rho_row(rho, rot);
#pragma unroll
                for (int s = 0; s < 4; ++s) {
                    float d = (qv[s][0] * kk[j][0] + qv[s][1] * kk[j][1]) + (qv[s][2] * kk[j][2] + qv[s][3] * kk[j][3]);
                    d = row16_sum(d);
                    const int t = 2048 + s - r;
                    if (t >= 0 && li == 0) { LAS float* base = SC + ((hl * 4 + s) * 3) * 132;
                        if (t <= 128) base[t] = d;
                        if ((t & 3) == 0 && (t >> 2) <= 128) base[132 + (t >> 2)] = d;
                        if ((t & 15) == 0 && (t >> 4) <= 128) base[264 + (t >> 4)] = d; }
                } } }
    }
    __syncthreads();
    for (int c = w; c < 48; c += 8) {
        LAS float* base = SC + c * 132;
        const float v0 = base[lane], v1 = base[64 + lane], v2 = (lane == 0) ? base[128] : -INFINITY;
        float mx = fmaxf(v0, fmaxf(v1, v2));
#pragma unroll
        for (int o = 1; o < 64; o <<= 1) mx = fmaxf(mx, __shfl_xor(mx, o));
        const float p0 = __expf(v0 - mx), p1 = __expf(v1 - mx), p2 = (lane == 0) ? __expf(v2 - mx) : 0.f;
        const float l = wave_sum(p0 + p1 + p2);
        base[lane] = p0; base[64 + lane] = p1; if (lane == 0) { base[128] = p2; ST[2 * c] = mx; ST[2 * c + 1] = l; }
    }
    __syncthreads();
    if (tid < 16) {
        float ls[3], cf[3], mxl = -INFINITY, den = 0.f;
#pragma unroll
        for (int i = 0; i < 3; ++i) { ls[i] = ST[2 * (tid * 3 + i)] + __logf(ST[2 * (tid * 3 + i) + 1]); mxl = fmaxf(mxl, ls[i]); }
#pragma unroll
        for (int i = 0; i < 3; ++i) { cf[i] = __expf(ls[i] - mxl); den += cf[i]; }
#pragma unroll
        for (int i = 0; i < 3; ++i) CF[tid * 3 + i] = cf[i] / (den * ST[2 * (tid * 3 + i) + 1]);
    }
    __syncthreads();
    for (int c = w; c < 48; c += 8) { LAS float* base = SC + c * 132; const float cf = CF[c]; base[lane] *= cf; base[64 + lane] *= cf; if (lane == 0) base[128] *= cf; }
    __syncthreads();
    f32x4 acc[4];
#pragma unroll
    for (int s = 0; s < 4; ++s) acc[s] = (f32x4){0.f, 0.f, 0.f, 0.f};
    for (int i0 = 0; i0 < 113; i0 += 8) {
        f32x4 vv[8];
#pragma unroll
        for (int j = 0; j < 8; ++j) { const int rho = w + 8 * (i0 + j); vv[j] = __builtin_nontemporal_load(samp_rowp(F.cv, ovn, bd, samp_rho_row(rho < 900 ? rho : 899, rot), hf, lane)); }
#pragma unroll
        for (int j = 0; j < 8; ++j) { const int rho = w + 8 * (i0 + j);
            if (rho < 900) { const int r = samp_rho_row(rho, rot);
#pragma unroll
                for (int s = 0; s < 4; ++s) { const int t = 2048 + s - r, tc = t < 0 ? 0 : t;
                    const LAS float* base = SC + ((hl * 4 + s) * 3) * 132;
                    const int i0 = tc > 128 ? 128 : tc, i1 = (tc >> 2) > 128 ? 128 : (tc >> 2), i2 = (tc >> 4) > 128 ? 128 : (tc >> 4);
                    const float m0 = (t >= 0 && t <= 128) ? 1.f : 0.f, m1 = (t >= 0 && (t & 3) == 0 && (t >> 2) <= 128) ? 1.f : 0.f, m2 = (t >= 0 && (t & 15) == 0 && (t >> 4) <= 128) ? 1.f : 0.f;
                    const float ws = base[i0] * m0 + base[132 + i1] * m1 + base[264 + i2] * m2;
                    acc[s] += vv[j] * ws; } } }
    }
#pragma unroll
    for (int s = 0; s < 4; ++s) *(LAS f32x4*)(RED + ((w * 4 + s) * 256 + lane * 4)) = acc[s];
    __syncthreads();
    for (int o = tid; o < 1024; o += 512) { const int s = o >> 8, col = o & 255; float a = 0.f;
#pragma unroll
        for (int w2 = 0; w2 < 8; ++w2) a += RED[(w2 * 4 + s) * 256 + col];
        F.Cat()[(size_t)(MP + bd * 4 + s) * 1024 + hf * 256 + col] = (bf16)f2bf(a); }
    __syncthreads();
}
__device__ __forceinline__ void hgrn_sample_unit(const Ctx& F, int u) {
    const int bd = u >> 2, hh = u & 3, tid = F.tid, lane = F.lane, w = F.wave;
    LAS float* part = (LAS float*)F.lds;
    LAS float* ssq = (LAS float*)(F.lds + 32768);
    const int v4 = tid & 31, kq = tid >> 5;
    const float* sp = F.st0 + ((size_t)u * 128 + 8 * kq) * 128 + 4 * v4;
    float* so = F.out + O_SS + ((size_t)u * 128 + 8 * kq) * 128 + 4 * v4;
    f32x4 S[8];
#pragma unroll
    for (int i = 0; i < 8; ++i) S[i] = *(const f32x4*)(sp + (size_t)i * 128);
#pragma unroll
    for (int s = 0; s < 4; ++s) {
        const size_t base = (size_t)(MP + bd * 4 + s) * 512 + hh * 128;
        const f32x4 kh0 = *(const f32x4*)(F.KH() + base + 8 * kq), kh1 = *(const f32x4*)(F.KH() + base + 8 * kq + 4);
        const f32x4 q0 = *(const f32x4*)(F.HQ() + base + 8 * kq), q1 = *(const f32x4*)(F.HQ() + base + 8 * kq + 4);
        const f32x4 iv = *(const f32x4*)(F.HI() + base + 4 * v4);
        f32x4 po = (f32x4){0.f, 0.f, 0.f, 0.f};
#pragma unroll
        for (int i = 0; i < 8; ++i) { const float kh = i < 4 ? kh0[i & 3] : kh1[i & 3], qq = i < 4 ? q0[i & 3] : q1[i & 3];
            S[i] = S[i] * (1.0f - kh) + iv * kh; po += S[i] * qq; }
        *(LAS f32x4*)(part + (s * 16 + kq) * 128 + 4 * v4) = po;
    }
#pragma unroll
    for (int i = 0; i < 8; ++i) *(f32x4*)(so + (size_t)i * 128) = S[i];
    __syncthreads();
    const int s = tid >> 7, v = tid & 127; float o = 0.f;
#pragma unroll
    for (int k2 = 0; k2 < 16; ++k2) o += part[(s * 16 + k2) * 128 + v];
    const float sq = wave_sum(o * o);
    if (lane == 0) ssq[w] = sq;
    __syncthreads();
    const float tot = ssq[2 * s] + ssq[2 * s + 1];
    const float rstd = 1.0f / sqrtf(tot * (1.0f / 128.0f) + LN_EPS);
    const size_t row = (size_t)(MP + bd * 4 + s); const int col = hh * 128 + v;
    F.Cat()[row * 1024 + 512 + col] = (bf16)f2bf(o * rstd * F.hng[col] * F.HG()[row * 512 + col]);
    __syncthreads();
}
constexpr int HG_QD = 0, HG_KD = 8704, HG_KET = 17408, HG_VT = 27648, HG_DEC = 37888, HG_QT = 38400, HG_SSQ = 40448;
template <bool FULL>
__device__ __forceinline__ float hgrn_prep(const Ctx& F, int b, int hh, int t0) {
    LAS unsigned char* L = F.lds; const int tid = F.tid, k = tid & 127, tq = tid >> 7;
    const size_t rbase = ((size_t)b * SEQ + t0 + 8 * tq) * 512 + hh * 128 + k;
    float cum[8];
#pragma unroll
    for (int i = 0; i < 8; ++i) cum[i] = F.LOGF()[rbase + (size_t)i * 512];
#pragma unroll
    for (int i = 1; i < 8; ++i) cum[i] += cum[i - 1];
    LAS float* QT = (LAS float*)(L + HG_QT);
    QT[tq * 128 + k] = cum[7];
    __syncthreads();
    float off = 0.f, tot = 0.f;
#pragma unroll
    for (int q2 = 0; q2 < 4; ++q2) { const float v = QT[q2 * 128 + k]; off += (q2 < tq) ? v : 0.f; tot += v; }
#pragma unroll
    for (int i = 0; i < 8; ++i) {
        const float c = cum[i] + off; const int t = 8 * tq + i;
        const float kh = F.KH()[rbase + (size_t)i * 512];
        if (FULL) { const float qv = F.HQ()[rbase + (size_t)i * 512];
            *(LAS u16*)(L + HG_QD + t * 272 + k * 2) = (u16)f2bf(qv * __expf(c));
            *(LAS u16*)(L + HG_KD + t * 272 + k * 2) = (u16)f2bf(kh * __expf(-c)); }
        *(LAS u16*)(L + HG_KET + k * 80 + t * 2) = (u16)f2bf(kh * __expf(tot - c));
        *(LAS u16*)(L + HG_VT + k * 80 + t * 2) = (u16)f2bf(F.HI()[rbase + (size_t)i * 512]);
    }
    if (tq == 0) *(LAS float*)(L + HG_DEC + k * 4) = __expf(tot);
    __syncthreads();
    return tot;
}
__device__ __forceinline__ void hgrn_update(const Ctx& F, f32x4 (&S)[8]) {
    LAS unsigned char* L = F.lds; const int c16 = F.lane & 15, g = F.lane >> 4, w = F.wave;
    const bf16x8 vB = *(const LAS bf16x8*)(L + HG_VT + (16 * w + c16) * 80 + (8 * g) * 2);
#pragma unroll
    for (int a = 0; a < 8; ++a) {
        const f32x4 dc = *(const LAS f32x4*)(L + HG_DEC + (16 * a + 4 * g) * 4);
        const bf16x8 keA = *(const LAS bf16x8*)(L + HG_KET + (16 * a + c16) * 80 + (8 * g) * 2);
        S[a] = MFMA16(keA, vB, S[a] * dc);
    }
}
__device__ __forceinline__ void hgrn_pass1_unit(const Ctx& F, int u) {
    const int bh = u >> 4, seg = u & 15, b = bh >> 2, hh = bh & 3;
    f32x4 S[8];
#pragma unroll
    for (int a = 0; a < 8; ++a) S[a] = (f32x4){0.f, 0.f, 0.f, 0.f};
    float dsum = 0.f;
    for (int c = 0; c < 8; ++c) { dsum += hgrn_prep<false>(F, b, hh, seg * 256 + c * 32); hgrn_update(F, S); __syncthreads(); }
    if (F.tid < 128) F.Dseg()[(size_t)u * 128 + F.tid] = __expf(dsum);
#pragma unroll
    for (int a = 0; a < 8; ++a) *(f32x4*)(F.Useg() + ((((size_t)u * 8 + F.wave) * 8 + a) * 64 + F.lane) * 4) = S[a];
}
__device__ __forceinline__ void hgrn_pass2_unit(const Ctx& F, int u) {
    LAS unsigned char* L = F.lds;
    const int bh = u >> 4, seg = u & 15, b = bh >> 2, hh = bh & 3, lane = F.lane, w = F.wave, c16 = lane & 15, g = lane >> 4;
    f32x4 S[8];
#pragma unroll
    for (int a = 0; a < 8; ++a) S[a] = (f32x4){0.f, 0.f, 0.f, 0.f};
    for (int sp = 0; sp < seg; ++sp) { const size_t pu = (size_t)bh * 16 + sp;
#pragma unroll
        for (int a = 0; a < 8; ++a) { const f32x4 dc = *(const f32x4*)(F.Dseg() + pu * 128 + 16 * a + 4 * g); const f32x4 U = *(const f32x4*)(F.Useg() + (((pu * 8 + w) * 8 + a) * 64 + lane) * 4); S[a] = S[a] * dc + U; } }
    for (int c = 0; c < 8; ++c) {
        const int t0 = seg * 256 + c * 32;
        (void)hgrn_prep<true>(F, b, hh, t0);
        f32x4 am[2][2];
#pragma unroll
        for (int jt = 0; jt < 2; ++jt)
#pragma unroll
            for (int it = 0; it < 2; ++it) am[jt][it] = (f32x4){0.f, 0.f, 0.f, 0.f};
#pragma unroll
        for (int s4 = 0; s4 < 4; ++s4) {
            bf16x8 kdA[2], qdB[2];
#pragma unroll
            for (int t2 = 0; t2 < 2; ++t2) { kdA[t2] = *(const LAS bf16x8*)(L + HG_KD + (16 * t2 + c16) * 272 + (32 * s4 + 8 * g) * 2); qdB[t2] = *(const LAS bf16x8*)(L + HG_QD + (16 * t2 + c16) * 272 + (32 * s4 + 8 * g) * 2); }
#pragma unroll
            for (int jt = 0; jt < 2; ++jt)
#pragma unroll
                for (int it = 0; it < 2; ++it) am[jt][it] = MFMA16(kdA[jt], qdB[it], am[jt][it]);
        }
#pragma unroll
        for (int jt = 0; jt < 2; ++jt)
#pragma unroll
            for (int it = 0; it < 2; ++it)
#pragma unroll
                for (int rg = 0; rg < 4; ++rg) if (16 * jt + 4 * g + rg > 16 * it + c16) am[jt][it][rg] = 0.f;
        f32x4 o[2];
        { const LAS unsigned char* vb = L + HG_VT + (16 * w + c16) * 80 + (4 * g) * 2;
          const bf16x8 vB = join8(*(const LAS u32x2*)vb, *(const LAS u32x2*)(vb + 32));
#pragma unroll
          for (int it = 0; it < 2; ++it) o[it] = MFMA16(pack8(am[0][it], am[1][it]), vB, ((f32x4){0.f, 0.f, 0.f, 0.f})); }
#pragma unroll
        for (int kp = 0; kp < 4; ++kp) {
            const bf16x8 sB = pack8(S[2 * kp], S[2 * kp + 1]);
#pragma unroll
            for (int it = 0; it < 2; ++it) { const LAS unsigned char* qp = L + HG_QD + (16 * it + c16) * 272 + (32 * kp + 4 * g) * 2;
                o[it] = MFMA16(join8(*(const LAS u32x2*)qp, *(const LAS u32x2*)(qp + 32)), sB, o[it]); }
        }
        hgrn_update(F, S);
        LAS float* SSQ = (LAS float*)(L + HG_SSQ);
#pragma unroll
        for (int it = 0; it < 2; ++it)
#pragma unroll
            for (int rg = 0; rg < 4; ++rg) { float sq = o[it][rg] * o[it][rg]; sq += __shfl_xor(sq, 1); sq += __shfl_xor(sq, 2); sq += __shfl_xor(sq, 4); sq += __shfl_xor(sq, 8);
                if (c16 == 0) SSQ[w * 32 + 16 * it + 4 * g + rg] = sq; }
        __syncthreads();
        const int col = hh * 128 + 16 * w + c16; const float ng = F.hng[col];
#pragma unroll
        for (int it = 0; it < 2; ++it)
#pragma unroll
            for (int rg = 0; rg < 4; ++rg) { const int i = 16 * it + 4 * g + rg; float tot = 0.f;
#pragma unroll
                for (int w2 = 0; w2 < 8; ++w2) tot += SSQ[w2 * 32 + i];
                const float rstd = 1.0f / sqrtf(tot * (1.0f / 128.0f) + LN_EPS);
                const size_t row = (size_t)b * SEQ + t0 + i;
                F.Cat()[row * 1024 + 512 + col] = (bf16)f2bf(o[it][rg] * rstd * ng * F.HG()[row * 512 + col]); }
        __syncthreads();
    }
    if (seg == 15) {
#pragma unroll
        for (int a = 0; a < 8; ++a)
#pragma unroll
            for (int rg = 0; rg < 4; ++rg) F.out[O_SP + ((size_t)bh * 128 + 16 * a + 4 * g + rg) * 128 + 16 * w + c16] = S[a][rg];
    }
}
struct Args { const float* in[21]; float* out; unsigned char* ws; };
__global__ void __launch_bounds__(NWAVES * 64, 2) fwd_kernel(Args args) {
    extern __shared__ __attribute__((aligned(16))) unsigned char lds[];
    Ctx F;
    F.lds = (LAS unsigned char*)lds;
    const int wave_s = __builtin_amdgcn_readfirstlane((int)threadIdx.x >> 6);
    F.tid = threadIdx.x; F.lane = F.tid & 63; F.wave = wave_s; F.G = gridDim.x; F.bid = blockIdx.x;
    F.xp = args.in[0]; F.xs = args.in[1]; F.ck = args.in[2]; F.cv = args.in[3]; F.st0 = args.in[4]; F.w1g = args.in[5]; F.w1u = args.in[6]; F.w1d = args.in[7]; F.ln1g = args.in[8]; F.ln1b = args.in[9];
    F.win = args.in[10]; F.hlb = args.in[11]; F.hng = args.in[12]; F.wout = args.in[13]; F.ln2g = args.in[14]; F.ln2b = args.in[15]; F.w2g = args.in[16]; F.w2u = args.in[17]; F.w2d = args.in[18]; F.ln3g = args.in[19]; F.ln3b = args.in[20];
    F.out = args.out; F.ws = args.ws; unsigned char* ws = args.ws;


    for (int u = F.tid; u < (LDS_BYTES - LDSCTL_OFF) / 4; u += NWAVES * 64) ((LAS unsigned*)(F.lds + LDSCTL_OFF))[u] = 0u;
    __syncthreads();
    XcdBarrier bar = xcd_barrier_post((unsigned*)(ws + WS_CTL) + CW_BAR, (volatile LAS unsigned*)(F.lds + MISC_OFF) + 8);
#define REFRESH() do { int l_ = (int)__builtin_amdgcn_mbcnt_hi(~0u, __builtin_amdgcn_mbcnt_lo(~0u, 0u)); asm volatile("" : "+v"(l_)); F.lane = l_; F.wave = wave_s; F.tid = wave_s * 64 + l_; } while (0)
#define GRID_BAR() do { xcd_barrier(bar); REFRESH(); } while (0)
#define COPY_SETUP(S, off4, n4_, R) do { const int cb_ = F.bid & 127; const float* sp_ = (F.bid < 128 ? F.ck : F.cv) + (size_t)cb_ * 1048576 + 2048; float* dp_ = F.out + (F.bid < 128 ? O_KS : O_VS) + (size_t)cb_ * 1048576; \
        (S).src = (const f32x4*)sp_ + (off4); (S).dst = (f32x4*)dp_ + (off4); (S).n4 = (F.G == 256) ? (n4_) : 0; (S).slot = (F.bid >> 3) % (R); (S).tid = F.tid; (S).cnt = 0; } while (0)

#if PHMASK & 1
    for (int rep_ = 0; rep_ < ((REPMASK & 1) ? 2 : 1); ++rep_) {
    p0_prologue(F);
    }
#endif
    GRID_BAR();
#if PHMASK & 2
    for (int rep_ = 0; rep_ < ((REPMASK & 2) ? 2 : 1); ++rep_) {
    { pg8::Gemm g{F.Xb(), F.W1gu(), M, NGU, D}; pg8::CopyOrder S; S.init(M, NGU, F.G, F.bid); COPY_SETUP(S, 0, 100352, 5); pg8::EpiSwiGLU E{F.Hb(), FF};
      pg8::gemm_phase<pg8::EpiSwiGLU, pg8::CopyOrder, true, true>(F.lds + RING_OFF, g, S, E, F.tid); }
    }
#endif
    GRID_BAR();
#if PHMASK & 4
    for (int rep_ = 0; rep_ < ((REPMASK & 4) ? 2 : 1); ++rep_) {
    { pg8::Gemm g{F.Hb(), F.W1d(), M, D, FF}; pg8::StaticOrder S; S.init(M, D, F.G, F.bid); pg8::EpiResid E{F.xp, F.xs, F.Ypre(), DN_ALPHA, 0.5f};
      pg8::gemm_phase<pg8::EpiResid, pg8::StaticOrder, true, true>(F.lds + RING_OFF, g, S, E, F.tid); }
    }
#endif
    GRID_BAR();
#if PHMASK & 8
    for (int rep_ = 0; rep_ < ((REPMASK & 8) ? 2 : 1); ++rep_) {
    ln_rows(F, F.Ypre(), F.ln1g, F.ln1b, F.X1(), F.X1b());
    }
#endif
    GRID_BAR();
#if PHMASK & 16
    for (int rep_ = 0; rep_ < ((REPMASK & 16) ? 2 : 1); ++rep_) {
    { pg8::Gemm g{F.X1b(), F.Win(), M, NIN, D}; pg8::CopyOrder S; S.init(M, NIN, F.G, F.bid); COPY_SETUP(S, 100352, 60928, 3);
      pg8::EpiWin E{F.Qb(), F.Kb(), F.Vb(), F.HQ(), F.LOGF(), F.KH(), F.HI(), F.HG(), F.COS(), F.SIN(), F.LB(), F.out + O_KP, F.out + O_VP, F.out + O_KS, F.out + O_VS};
      pg8::gemm_phase<pg8::EpiWin, pg8::CopyOrder, true, true>(F.lds + RING_OFF, g, S, E, F.tid); }
    }
#endif
    GRID_BAR();
#if PHMASK & 32
    for (int rep_ = 0; rep_ < ((REPMASK & 32) ? 2 : 1); ++rep_) {
    for (int u = F.bid; u < 256; u += F.G) hgrn_pass1_unit(F, u);
    }
#endif
#if PHMASK & 64
    for (int rep_ = 0; rep_ < ((REPMASK & 64) ? 2 : 1); ++rep_) {
    for (int u = F.bid; u < 3072; u += F.G) attn_prompt_unit(F, u);
    }
#endif
#if PHMASK & 128
    for (int rep_ = 0; rep_ < ((REPMASK & 128) ? 2 : 1); ++rep_) {
    for (int u = F.bid; u < 256; u += F.G) attn_sample_unit(F, u);
    }
#endif
#if PHMASK & 256
    for (int rep_ = 0; rep_ < ((REPMASK & 256) ? 2 : 1); ++rep_) {
    for (int u = F.bid; u < 512; u += F.G) hgrn_sample_unit(F, u);
    }
#endif
    GRID_BAR();
#if PHMASK & 512
    for (int rep_ = 0; rep_ < ((REPMASK & 512) ? 2 : 1); ++rep_) {
    for (int u = F.bid; u < 256; u += F.G) hgrn_pass2_unit(F, u);
    }
#endif
#if PHMASK & 1024
    for (int rep_ = 0; rep_ < ((REPMASK & 1024) ? 2 : 1); ++rep_) {
    attn_combine_rows(F);
    }
#endif
    GRID_BAR();
#if PHMASK & 2048
    for (int rep_ = 0; rep_ < ((REPMASK & 2048) ? 2 : 1); ++rep_) {
    { pg8::Gemm g{F.Cat(), F.Wout(), M, D, D}; pg8::StaticOrder S; S.init(M, D, F.G, F.bid); pg8::EpiResid E{F.X1(), F.X1() + (size_t)MP * D, F.Ypre(), DN_ALPHA, 1.0f};
      pg8::gemm_phase<pg8::EpiResid, pg8::StaticOrder, true, true>(F.lds + RING_OFF, g, S, E, F.tid); }
    }
#endif
    GRID_BAR();
    ln_rows(F, F.Ypre(), F.ln2g, F.ln2b, F.X2(), F.X2b());
    GRID_BAR();
    { pg8::Gemm g{F.X2b(), F.W2gu(), M, NGU, D}; pg8::CopyOrder S; S.init(M, NGU, F.G, F.bid); COPY_SETUP(S, 161280, 100352, 5); pg8::EpiSwiGLU E{F.Hb(), FF};
      pg8::gemm_phase<pg8::EpiSwiGLU, pg8::CopyOrder, true, true>(F.lds + RING_OFF, g, S, E, F.tid); }
    GRID_BAR();
    { pg8::Gemm g{F.Hb(), F.W2d(), M, D, FF}; pg8::StaticOrder S; S.init(M, D, F.G, F.bid); pg8::EpiResid E{F.X2(), F.X2() + (size_t)MP * D, F.Ypre(), DN_ALPHA, 0.5f};
      pg8::gemm_phase<pg8::EpiResid, pg8::StaticOrder, true, true>(F.lds + RING_OFF, g, S, E, F.tid); }
    GRID_BAR();
    ln_rows(F, F.Ypre(), F.ln3g, F.ln3b, F.out + O_YP, (bf16*)nullptr);
}
#if DBG
constexpr int DBG_NST = 14, DBG_NS = 6;
__device__ __forceinline__ unsigned dhash(unsigned x) { x ^= x >> 16; x *= 0x7feb352dU; x ^= x >> 15; x *= 0x846ca68bU; x ^= x >> 16; return x; }
__device__ __forceinline__ float dbf(bf16 h) { return bf2f((unsigned)h); }
__device__ __forceinline__ float rbf(float x) { return bf2f(f2bf(x)); }
__device__ __forceinline__ float dsig(float x) { return 1.0f / (1.0f + __expf(-x)); }
__device__ __forceinline__ void dmax(unsigned* slot, float e) { unsigned b = (e != e) ? 0x7fc00000u : __builtin_bit_cast(unsigned, fabsf(e)); atomicMax(slot, b); }
__device__ __forceinline__ float block_sum1024(float v, float* sh) {
    v = wave_sum(v); __syncthreads(); if ((threadIdx.x & 63) == 0) sh[threadIdx.x >> 6] = v; __syncthreads(); float t = 0.f; for (int i = 0; i < 16; ++i) t += sh[i]; __syncthreads(); return t;
}
__device__ void dbg_ffn_row(const float* res, const bf16* xb, const bf16* Wgu, const bf16* Wd, const float* lg, const float* lb, const float* got, unsigned* slot, float* hs, float* ys, float* sh) {
    const int tid = threadIdx.x;
    for (int hc = tid; hc < FF; hc += 1024) {
        const bf16* wg = Wgu + (size_t)(256 * (hc >> 7) + (hc & 127)) * D; const bf16* wu = wg + (size_t)128 * D; float g = 0.f, u = 0.f;
        for (int k = 0; k < D; ++k) { const float x = dbf(xb[k]); g += x * dbf(wg[k]); u += x * dbf(wu[k]); }
        hs[hc] = rbf(g * dsig(g) * u);
    }
    __syncthreads();
    float acc = 0.f; { const bf16* wd = Wd + (size_t)tid * FF; for (int j = 0; j < FF; ++j) acc += hs[j] * dbf(wd[j]); }
    const float y = DN_ALPHA * res[tid] + 0.5f * acc;
    const float mean = block_sum1024(y, sh) * (1.f / D); const float var = block_sum1024((y - mean) * (y - mean), sh) * (1.f / D);
    const float want = (y - mean) / sqrtf(var + LN_EPS) * lg[tid] + lb[tid];
    dmax(slot, (got[tid] - want)); (void)ys;
}
__global__ void __launch_bounds__(1024, 1) dbg_check(Args args) {
    __shared__ float hs[FF]; __shared__ float ys[1024]; __shared__ float sh[64]; __shared__ float ov[128];
    Ctx F; unsigned char* ws = args.ws;
    F.xp = args.in[0]; F.xs = args.in[1]; F.ck = args.in[2]; F.cv = args.in[3]; F.st0 = args.in[4]; F.w1g = args.in[5]; F.w1u = args.in[6]; F.w1d = args.in[7]; F.ln1g = args.in[8]; F.ln1b = args.in[9];
    F.win = args.in[10]; F.hlb = args.in[11]; F.hng = args.in[12]; F.wout = args.in[13]; F.ln2g = args.in[14]; F.ln2b = args.in[15]; F.w2g = args.in[16]; F.w2u = args.in[17]; F.w2d = args.in[18]; F.ln3g = args.in[19]; F.ln3b = args.in[20];
    F.out = args.out; F.ws = ws;


    unsigned* DB = (unsigned*)(ws + WS_DBG);
    const int stage = blockIdx.x / DBG_NS, smp = blockIdx.x % DBG_NS, tid = threadIdx.x;
    unsigned* slot = DB + stage;
    const unsigned hb = dhash(blockIdx.x * 7919u + 13u), ht = dhash(hb + tid * 2654435761u);
    if (stage == 0) {
        { const int c = ht % FF, k = dhash(ht + 1) % D; dmax(slot, dbf(F.W1gu()[(size_t)(256 * (c >> 7) + (c & 127)) * D + k]) - rbf(F.w1g[(size_t)k * FF + c])); dmax(slot, dbf(F.W1gu()[(size_t)(256 * (c >> 7) + 128 + (c & 127)) * D + k]) - rbf(F.w1u[(size_t)k * FF + c]));
          dmax(slot, dbf(F.W2gu()[(size_t)(256 * (c >> 7) + (c & 127)) * D + k]) - rbf(F.w2g[(size_t)k * FF + c])); dmax(slot, dbf(F.W2gu()[(size_t)(256 * (c >> 7) + 128 + (c & 127)) * D + k]) - rbf(F.w2u[(size_t)k * FF + c])); }
        { const int c = ht % D, k = dhash(ht + 2) % FF; dmax(slot, dbf(F.W1d()[(size_t)c * FF + k]) - rbf(F.w1d[(size_t)k * D + c])); dmax(slot, dbf(F.W2d()[(size_t)c * FF + k]) - rbf(F.w2d[(size_t)k * D + c])); }
        { const int c = ht % NIN, k = dhash(ht + 3) % D; dmax(slot, dbf(F.Win()[(size_t)RmWin()(c) * D + k]) - rbf(F.win[(size_t)k * NIN + c])); }
        { const int c = ht % D, k = dhash(ht + 4) % D; dmax(slot, dbf(F.Wout()[(size_t)c * D + k]) - rbf(F.wout[(size_t)k * D + c])); }
    } else if (stage == 1) {
        const int m = ht % M, c = dhash(ht + 1) % D; const float x = m < MP ? F.xp[(size_t)m * D + c] : F.xs[(size_t)(m - MP) * D + c]; dmax(slot, dbf(F.Xb()[(size_t)m * D + c]) - rbf(x));
    } else if (stage == 2) {
        const int pi = (smp == 0 && tid < 8) ? 4092 + tid : (int)(ht % 4100), i = dhash(ht + 1) & 31; const int pos = pi < 4096 ? pi : 8192 + (pi - 4096);
        const float ang = (float)pos * INV_FREQ[i]; double r = (double)ang; r -= 6.283185307179586 * __builtin_rint(r * 0.15915494309189535);
        double sn = 0., cs = 0., term = 1.; for (int n = 0; n < 30; ++n) { if (n & 1) sn += ((n >> 1) & 1) ? -term : term; else cs += ((n >> 1) & 1) ? -term : term; term *= r / (double)(n + 1); }
        dmax(slot, F.COS()[pi * 32 + i] - (float)cs); dmax(slot, F.SIN()[pi * 32 + i] - (float)sn);
    } else if (stage == 3) {
        if (tid < 512) { const float a0 = F.hlb[tid], a1 = F.hlb[512 + tid]; dmax(slot, F.LB()[tid] - 1.0f / (1.0f + expf(a1 - a0))); }
    } else if (stage == 4) {
        const int b = ht & 127, rr = dhash(ht + 1) % 2044, c = dhash(ht + 2) & 511;
        dmax(slot, F.out[O_KS + ((size_t)b * 2048 + rr) * 512 + c] - F.ck[((size_t)b * 2048 + rr + 4) * 512 + c]); dmax(slot, F.out[O_VS + ((size_t)b * 2048 + rr) * 512 + c] - F.cv[((size_t)b * 2048 + rr + 4) * 512 + c]);
    } else if (stage == 5 || stage == 13) {
        const int m = (smp < 4) ? (int)(hb % MP) : MP + (int)(hb % MS);
        if (stage == 5) dbg_ffn_row(m < MP ? F.xp + (size_t)m * D : F.xs + (size_t)(m - MP) * D, F.Xb() + (size_t)m * D, F.W1gu(), F.W1d(), F.ln1g, F.ln1b, F.X1() + (size_t)m * D, slot, hs, ys, sh);
        else dbg_ffn_row(F.X2() + (size_t)m * D, F.X2b() + (size_t)m * D, F.W2gu(), F.W2d(), F.ln3g, F.ln3b, F.out + O_YP + (size_t)m * D, slot, hs, ys, sh);
    } else if (stage == 6) {
        const int m = (tid & 3) ? (int)(ht % MP) : ((tid & 4) ? MP + (int)(ht % MS) : (int)((ht % 4) * SEQ + 2048 + (dhash(ht + 9) % 2048))); const int col = dhash(ht + 1) % NIN;
        const int typ = col >> 9, c5 = col & 511; const bf16* xr = F.X1b() + (size_t)m * D;
        const int pi = m < MP ? (m & 4095) : 4096 + ((m - MP) & 3);
        float* fk = nullptr; if (m >= MP) fk = F.out + ((size_t)(((m - MP) >> 2) * 2048 + 2044 + ((m - MP) & 3))) * 512; else if ((m & 4095) >= 2048) fk = F.out + ((size_t)((m >> 12) * 2048 + (m & 4095) - 2048)) * 512;
        if (typ <= 1) {
            const int e = c5 & 63, e1 = e & 31, cb = col - e; float x1 = 0.f, x2 = 0.f; const bf16* w1 = F.Win() + (size_t)RmWin()(cb + e1) * D; const bf16* w2 = F.Win() + (size_t)RmWin()(cb + e1 + 32) * D;
            for (int k = 0; k < D; ++k) { const float x = dbf(xr[k]); x1 += x * dbf(w1[k]); x2 += x * dbf(w2[k]); }
            const float cs = F.COS()[pi * 32 + e1], sn = F.SIN()[pi * 32 + e1]; const float want = e < 32 ? x1 * cs - x2 * sn : x2 * cs + x1 * sn;
            const float got = dbf((typ == 0 ? F.Qb() : F.Kb())[(size_t)m * 512 + c5]); dmax(slot, (got - want) / (fabsf(want) + 0.2f));
            if (typ == 1 && fk) dmax(slot, (fk[(m >= MP ? O_KS : O_KP) + c5] - want) / (fabsf(want) + 0.2f));
        } else {
            float z = 0.f; const bf16* w1 = F.Win() + (size_t)col * D; for (int k = 0; k < D; ++k) z += dbf(xr[k]) * dbf(w1[k]);
            const size_t off = (size_t)m * 512 + c5;
            if (typ == 2) { dmax(slot, (dbf(F.Vb()[off]) - z) / (fabsf(z) + 0.1f)); if (fk) dmax(slot, (fk[(m >= MP ? O_VS : O_VP) + c5] - z) / (fabsf(z) + 0.1f)); }
            else if (typ == 3) dmax(slot, (F.HQ()[off] - z * dsig(z)) / (fabsf(z) + 0.1f));
            else if (typ == 4) { const float lb = 1.0f / (1.0f + expf(F.hlb[512 + c5] - F.hlb[c5])); const float f = lb + (1.f - lb) * dsig(z); dmax(slot, F.LOGF()[off] - logf(f)); dmax(slot, F.KH()[off] - (1.f - f)); }
            else if (typ == 5) dmax(slot, (F.HI()[off] - z) / (fabsf(z) + 0.1f));
            else dmax(slot, (F.HG()[off] - z * dsig(z)) / (fabsf(z) + 0.1f));
        }
    } else if (stage == 7 || stage == 8) {
        const int wv = tid >> 6, e = tid & 63; const unsigned hw = dhash(hb + wv * 977u);
        const int h = hw & 7; int m; if (stage == 7) { const int tsel = (wv & 3) == 0 ? (int)(dhash(hw + 1) % 140) : (int)(dhash(hw + 1) % SEQ); m = (int)(dhash(hw + 2) % 4) * SEQ + tsel; } else m = MP + (int)(dhash(hw + 1) % MS);
        const float qe = dbf(F.Qb()[(size_t)m * 512 + h * 64 + e]);
        float lse[3], ob[3];
        for (int di = 0; di < 3; ++di) {
            const int d = 1 << (2 * di); float mx = -INFINITY, l = 0.f, acc = 0.f;
            for (int j = 0; j <= 128; ++j) {
                float kv, vv;
                if (stage == 7) { const int t = (m & 4095) - d * j; if (t < 0) break; const size_t r = (size_t)(m - (m & 4095) + t) * 512 + h * 64 + e; kv = dbf(F.Kb()[r]); vv = dbf(F.Vb()[r]); }
                else { const int bd = (m - MP) >> 2, s = (m - MP) & 3, idx = 2048 + s - d * j; const size_t r = idx < 2048 ? ((size_t)(bd * 2048 + idx) * 512 + h * 64 + e) : ((size_t)(bd * 2048 + 2044 + idx - 2048) * 512 + h * 64 + e);
                       kv = idx < 2048 ? F.ck[r] : F.out[O_KS + r]; vv = idx < 2048 ? F.cv[r] : F.out[O_VS + r]; }
                const float sc = wave_sum(qe * kv) * 0.125f; const float nm = fmaxf(mx, sc); const float corr = __expf(mx - nm), p = __expf(sc - nm); l = l * corr + p; acc = acc * corr + p * vv; mx = nm;
            }
            lse[di] = mx + logf(l); ob[di] = acc / l;
        }
        const float ml = fmaxf(lse[0], fmaxf(lse[1], lse[2])); const float w0 = __expf(lse[0] - ml), w1 = __expf(lse[1] - ml), w2 = __expf(lse[2] - ml);
        const float want = (w0 * ob[0] + w1 * ob[1] + w2 * ob[2]) / (w0 + w1 + w2);
        dmax(slot, (dbf(F.Cat()[(size_t)m * 1024 + h * 64 + e]) - want) / (fabsf(want) + 0.05f));
    } else if (stage == 9 || stage == 10) {
        const int k = tid & 127, vg = tid >> 7; float S[16];
        int b = 0, hh = hb & 3, tt = 0, nstep; size_t row0;
        if (stage == 9) { b = (hb >> 2) & 3; tt = smp == 0 ? 3 : smp == 1 ? 40 : smp == 2 ? 300 : smp == 3 ? 1500 : smp == 4 ? 4095 : 2047; nstep = tt + 1; row0 = (size_t)b * SEQ;
#pragma unroll
            for (int i = 0; i < 16; ++i) S[i] = 0.f; }
        else { b = (hb >> 2) & 127; nstep = 4; tt = 3; row0 = (size_t)MP + b * 4;
#pragma unroll
            for (int i = 0; i < 16; ++i) S[i] = F.st0[((size_t)(b * 4 + hh) * 128 + k) * 128 + 16 * vg + i]; }
        for (int t = 0; t < nstep; ++t) { const size_t base = (row0 + t) * 512 + hh * 128; const float kh = F.KH()[base + k], f = __expf(F.LOGF()[base + k]);
#pragma unroll
            for (int i = 0; i < 16; ++i) S[i] = f * S[i] + kh * F.HI()[base + 16 * vg + i];
            if (t == tt || stage == 10) {
                const float q = F.HQ()[base + k];
#pragma unroll
                for (int i = 0; i < 16; ++i) { const float ps = wave_sum(q * S[i]); if ((tid & 63) == 0) sh[(tid >> 6) * 1 + 0] = ps; __syncthreads(); if (k == 0) ov[16 * vg + i] = sh[2 * vg] + sh[2 * vg + 1]; __syncthreads(); }
                float ssq = 0.f; for (int v = 0; v < 128; ++v) ssq += ov[v] * ov[v];
                const float rstd = 1.0f / sqrtf(ssq / 128.f + LN_EPS);
                if (tid < 128) { const int col = hh * 128 + tid; const float want = ov[tid] * rstd * F.hng[col] * F.HG()[(row0 + t) * 512 + col]; dmax(slot, (dbf(F.Cat()[(row0 + t) * 1024 + 512 + col]) - want) / (fabsf(want) + 0.05f)); }
                __syncthreads();
            }
        }
        if (stage == 10) { for (int i = 0; i < 16; ++i) dmax(slot, (F.out[O_SS + ((size_t)(b * 4 + hh) * 128 + k) * 128 + 16 * vg + i] - S[i]) / (fabsf(S[i]) + 0.1f)); }
        else if (tt == 4095) { for (int i = 0; i < 16; ++i) dmax(slot, (F.out[O_SP + ((size_t)(b * 4 + hh) * 128 + k) * 128 + 16 * vg + i] - S[i]) / (fabsf(S[i]) + 0.1f)); }
    } else if (stage == 11) {
        const int m = (smp < 4) ? (int)(hb % MP) : MP + (int)(hb % MS); float acc = 0.f; const bf16* cr = F.Cat() + (size_t)m * D; const bf16* wr = F.Wout() + (size_t)tid * D;
        for (int k = 0; k < D; ++k) acc += dbf(cr[k]) * dbf(wr[k]);
        const float y = DN_ALPHA * F.X1()[(size_t)m * D + tid] + acc;
        const float mean = block_sum1024(y, sh) * (1.f / D); const float var = block_sum1024((y - mean) * (y - mean), sh) * (1.f / D);
        const float want = (y - mean) / sqrtf(var + LN_EPS) * F.ln2g[tid] + F.ln2b[tid];
        dmax(slot, F.X2()[(size_t)m * D + tid] - want); dmax(slot, dbf(F.X2b()[(size_t)m * D + tid]) - rbf(F.X2()[(size_t)m * D + tid]));
    } else if (stage == 12) {
        const int m = ht % M, hc = dhash(ht + 1) % FF; const bf16* xr = F.X2b() + (size_t)m * D; const bf16* wg = F.W2gu() + (size_t)(256 * (hc >> 7) + (hc & 127)) * D; const bf16* wu = wg + (size_t)128 * D; float g = 0.f, u = 0.f;
        for (int k = 0; k < D; ++k) { const float x = dbf(xr[k]); g += x * dbf(wg[k]); u += x * dbf(wu[k]); }
        const float want = g * dsig(g) * u; dmax(slot, (dbf(F.Hb()[(size_t)m * FF + hc]) - want) / (fabsf(want) + 0.05f));
    }
}
__constant__ float DBG_TOL[DBG_NST] = {1e-6f, 1e-6f, 1e-4f, 1e-5f, 0.f, 5e-3f, 3e-2f, 4e-2f, 4e-2f, 6e-2f, 6e-2f, 5e-3f, 3e-2f, 5e-3f};
__global__ void dbg_emit(Args args) {
    if (threadIdx.x != 0) return;
    const unsigned* DB = (const unsigned*)(args.ws + WS_DBG);
    for (int s = 0; s < DBG_NST; ++s) {
        const float e = __builtin_bit_cast(float, DB[s]);
        if (!(e <= DBG_TOL[s])) {
            float mant = 9.5f; if (e == e) { float q = -10.0f * log10f(fmaxf(e, 1e-8f)); q = fminf(fmaxf(q, 0.f), 80.f); mant = 1.0f + floorf(q + 0.5f) / 10.0f; }
            float c = mant * 1e4f; for (int i = 0; i < s; ++i) c *= 10.0f;
            args.out[0] = c; return;
        }
    }
}
#define DBG_LAUNCH() do { (void)hipMemsetAsync((char*)d_ws + WS_DBG, 0, 4096, stream); hipLaunchKernelGGL(dbg_check, dim3(DBG_NST * DBG_NS), dim3(1024), 0, stream, a); hipLaunchKernelGGL(dbg_emit, dim3(1), dim3(64), 0, stream, a); } while (0)
#else
#define DBG_LAUNCH() do { } while (0)
#endif
extern "C" void kernel_launch(void* const* d_in, const int* in_sizes, int n_in, void* d_out, int out_size, void* d_ws, size_t ws_size, hipStream_t stream) {
    static int grid = 0;
    if (grid == 0) {
        if (n_in != 21 || (size_t)out_size != O_END || ws_size < WS_END) { fprintf(stderr, "kernel_launch: unexpected sizes n_in %d out %d ws %zu\n", n_in, out_size, ws_size); grid = -1; return; }
        int dev = 0, cus = 0, per_cu = 0;
        if (hipGetDevice(&dev) != hipSuccess || hipDeviceGetAttribute(&cus, hipDeviceAttributeMultiprocessorCount, dev) != hipSuccess) { grid = -1; return; }
        if (hipFuncSetAttribute((const void*)fwd_kernel, hipFuncAttributeMaxDynamicSharedMemorySize, LDS_BYTES) != hipSuccess) { fprintf(stderr, "kernel_launch: hipFuncSetAttribute failed\n"); grid = -1; return; }
        if (hipOccupancyMaxActiveBlocksPerMultiprocessor(&per_cu, (const void*)fwd_kernel, NWAVES * 64, LDS_BYTES) != hipSuccess || per_cu < 1) { fprintf(stderr, "kernel_launch: occupancy query says %d\n", per_cu); }
        (void)hipGetLastError();
        grid = cus;
    }
    if (grid < 0) return;
    if (hipMemsetAsync((char*)d_ws + WS_CTL, 0, CTL_ZERO_BYTES, stream) != hipSuccess) return;
    Args a{};
    for (int i = 0; i < 21; ++i) a.in[i] = (const float*)d_in[i];
    a.out = (float*)d_out; a.ws = (unsigned char*)d_ws;
    hipLaunchKernelGGL(fwd_kernel, dim3(grid), dim3(NWAVES * 64), LDS_BYTES, stream, a);
    DBG_LAUNCH();
}
```

```cpp
#ifndef DBG
#define DBG 0
#endif
#ifndef REPMASK
#define REPMASK 0
#endif
#ifndef PHMASK
#define PHMASK 0xFFFF
#endif
#include <hip/hip_runtime.h>
#include <cstdio>
#include <cstdint>
namespace pg8 {
#define PG8_LAS __attribute__((address_space(3)))
typedef unsigned short bf16_t;
typedef short bf16x8 __attribute__((ext_vector_type(8)));
typedef float f32x4 __attribute__((ext_vector_type(4)));
typedef unsigned u32x4 __attribute__((ext_vector_type(4)));
constexpr int BM = 256, BK = 64, HALF = 128, HTB = HALF * BK * 2  , STAGE_BYTES = 8 * HTB, NXCD = 8, WGM = 8;

__host__ __device__ __forceinline__ int lds_byte(int r, int c) { const int st = (r >> 4) * 2 + (c >> 5), rr = r & 15, cc = c & 31, ob = rr * 64 + cc * 2; return st * 1024 + (ob ^ (((ob >> 9) & 1) << 5)); }
__host__ __device__ __forceinline__ void stage_rc(int b, int& R, int& C) { const int st = b / 1024, sb = b % 1024, swz = sb ^ (((sb >> 9) & 1) << 5); R = (st >> 1) * 16 + swz / 64; C = (st & 1) * 32 + (swz % 64) / 2; }
__host__ __device__ __forceinline__ int perm32(int rho) { const int n = rho >> 4, i = rho & 15; return 8 * (i >> 2) + 4 * n + (i & 3); }

struct Unit { int pm, pn, ks; };
struct Gemm { const bf16_t* A; const bf16_t* Bt; int M, N, K, ld; };

struct StaticOrder {
    int nM, nN, nwg, G, c;
    __host__ __device__ void init(int M, int N, int G_, int c_) { nM = M / BM; nN = N / BM; nwg = nM * nN; G = G_; c = c_; }
    __host__ __device__ bool next(int i, Unit& u) const {
        const long L = (long)i * G + c; if (L >= nwg) return false;
        int wgid = (int)L; { const int q = nwg / NXCD, r = nwg % NXCD, xcd = wgid % NXCD, off = wgid / NXCD; wgid = (xcd < r ? xcd * (q + 1) : r * (q + 1) + (xcd - r) * q) + off; }
        const int nig = WGM * nN, gid = wgid / nig, fm = gid * WGM, gsz = (nM - fm) < WGM ? (nM - fm) : WGM;
        u.pm = fm + ((wgid % nig) % gsz); u.pn = (wgid % nig) / gsz; u.ks = 0; return true;
    }
    __device__ __forceinline__ void a_ready(const Unit&) const {}
    __device__ __forceinline__ void done(const Unit&) const {}
};

__device__ __forceinline__ void copy_piece(const f32x4* src, f32x4* dst, int n4, int tid) {
    constexpr int BT = 16, STEP = 512 * BT;
    asm volatile("" : "+v"(tid));
    f32x4 a[BT], b[BT];
#pragma unroll
    for (int j = 0; j < BT; ++j) if (tid + 512 * j < n4) a[j] = __builtin_nontemporal_load(src + tid + 512 * j);
    for (int i = tid; i < n4; i += 2 * STEP) {
#pragma unroll
        for (int j = 0; j < BT; ++j) if (i + STEP + 512 * j < n4) b[j] = __builtin_nontemporal_load(src + i + STEP + 512 * j);
#pragma unroll
        for (int j = 0; j < BT; ++j) if (i + 512 * j < n4) __builtin_nontemporal_store(a[j], dst + i + 512 * j);
#pragma unroll
        for (int j = 0; j < BT; ++j) if (i + 2 * STEP + 512 * j < n4) a[j] = __builtin_nontemporal_load(src + i + 2 * STEP + 512 * j);
#pragma unroll
        for (int j = 0; j < BT; ++j) if (i + STEP + 512 * j < n4) __builtin_nontemporal_store(b[j], dst + i + STEP + 512 * j);
    }
}
struct CopyOrder : StaticOrder {
    const f32x4* src; f32x4* dst; int n4, slot, tid; mutable int cnt;
    __device__ __forceinline__ void done(const Unit&) const { if (cnt++ == slot) copy_piece(src, dst, n4, tid); }
};

struct SplitOrder {
    int n, G, c;
    __device__ __forceinline__ bool next(int i, Unit& u) const { const int L = i * G + c; if (L >= n) return false; u.ks = L >> 3; u.pm = 64 + ((L & 7) >> 2); u.pn = L & 3; return true; }
    __device__ __forceinline__ void a_ready(const Unit&) const {}
    __device__ __forceinline__ void done(const Unit&) const {}
};
__device__ __forceinline__ unsigned cvt_pk_bf16(float lo, float hi) { unsigned r; asm volatile("v_cvt_pk_bf16_f32 %0, %1, %2" : "=v"(r) : "v"(lo), "v"(hi)); return r; }
typedef float f32x2 __attribute__((ext_vector_type(2)));
typedef unsigned u32x2 __attribute__((ext_vector_type(2)));
__device__ __forceinline__ float fsig(float x) { return __builtin_amdgcn_rcpf(1.0f + __expf(-x)); }
__device__ __forceinline__ float fsilu(float x) { return x * fsig(x); }

struct EpiSwiGLU {
    static constexpr bool PERM = true, AFTER_DRAIN = false;
    bf16_t* H; int ldh;
    __device__ __forceinline__ void operator()(const f32x4 (&acc)[2][2][4][2], const Unit& u, int wr, int wc, int fr, int fq) const {
        const int row0 = u.pm * BM + wr * 64 + fr, col0 = u.pn * HALF + wc * 32 + 8 * fq;
#pragma unroll
        for (int ai = 0; ai < 2; ++ai)
#pragma unroll
            for (int m = 0; m < 4; ++m) {
                bf16_t* p = H + (size_t)(row0 + ai * HALF + m * 16) * ldh + col0;
                const f32x4 g0 = acc[ai][0][m][0], g1 = acc[ai][0][m][1], u0 = acc[ai][1][m][0], u1 = acc[ai][1][m][1];
                float h[8];
#pragma unroll
                for (int i = 0; i < 4; ++i) { h[i] = fsilu(g0[i]) * u0[i]; h[4 + i] = fsilu(g1[i]) * u1[i]; }
                u32x4 w; w.x = cvt_pk_bf16(h[0], h[1]); w.y = cvt_pk_bf16(h[2], h[3]); w.z = cvt_pk_bf16(h[4], h[5]); w.w = cvt_pk_bf16(h[6], h[7]);
                *(u32x4*)p = w;
            }
    }
};

struct EpiResid {
    static constexpr bool PERM = false, AFTER_DRAIN = false;
    const float* resP; const float* resS; float* out; float alpha, scale;
    __device__ __forceinline__ void operator()(const f32x4 (&acc)[2][2][4][2], const Unit& u, int wr, int wc, int fr, int fq) const {
        const int row0 = u.pm * BM + wr * 64 + fr, col0 = u.pn * BM + wc * 32 + 4 * fq;
#pragma unroll
        for (int ai = 0; ai < 2; ++ai)
#pragma unroll
            for (int m = 0; m < 4; ++m) {
                const int row = row0 + ai * HALF + m * 16;
                const float* rb = (row < 16384) ? resP + (size_t)row * 1024 : resS + (size_t)(row - 16384) * 1024;
                float* ob = out + (size_t)row * 1024;
#pragma unroll
                for (int bj = 0; bj < 2; ++bj)
#pragma unroll
                    for (int n = 0; n < 2; ++n) { const int col = col0 + bj * HALF + n * 16;
                        const f32x4 r = *(const f32x4*)(rb + col); *(f32x4*)(ob + col) = r * alpha + acc[ai][bj][m][n] * scale; }
            }
    }
};

struct EpiPartial {
    static constexpr bool PERM = false, AFTER_DRAIN = false;
    float* slab;
    __device__ __forceinline__ void operator()(const f32x4 (&acc)[2][2][4][2], const Unit& u, int wr, int wc, int fr, int fq) const {
        const int row0 = (u.pm - 64) * BM + wr * 64 + fr, col0 = u.pn * BM + wc * 32 + 4 * fq;
#pragma unroll
        for (int ai = 0; ai < 2; ++ai)
#pragma unroll
            for (int m = 0; m < 4; ++m) { float* ob = slab + ((size_t)u.ks * 512 + row0 + ai * HALF + m * 16) * 1024;
#pragma unroll
                for (int bj = 0; bj < 2; ++bj)
#pragma unroll
                    for (int n = 0; n < 2; ++n) *(f32x4*)(ob + col0 + bj * HALF + n * 16) = acc[ai][bj][m][n]; }
    }
};

struct EpiWin {
    static constexpr bool PERM = false, AFTER_DRAIN = false;
    bf16_t *Qb, *Kb, *Vb; float *HQ, *LOGF, *KH, *HI, *HG; const float *COS, *SIN, *LB;
    float *okp, *ovp, *oks, *ovs;
    __device__ __forceinline__ float* kvdst(float* op, float* os, int row) const {
        if (row < 16384) { const int t = row & 4095, b = row >> 12; return (t >= 2048) ? op + (size_t)(b * 2048 + (t - 2048)) * 512 : (float*)nullptr; }
        const int r = row - 16384; return os + (size_t)((r >> 2) * 2048 + 2044 + (r & 3)) * 512;
    }
    __device__ __forceinline__ void operator()(const f32x4 (&acc)[2][2][4][2], const Unit& u, int wr, int wc, int fr, int fq) const {
        const int typ = u.pn >> 1, cbase = (u.pn & 1) * 256;
        const int row0 = u.pm * BM + wr * 64 + fr;
        if (typ <= 1) {
            bf16_t* dstb = typ == 0 ? Qb : Kb;
            const int e0 = 16 * (wc & 1) + 4 * fq;
#pragma unroll
            for (int ai = 0; ai < 2; ++ai)
#pragma unroll
                for (int m = 0; m < 4; ++m) {
                    const int row = row0 + ai * HALF + m * 16;
                    const int pi = (row < 16384) ? (row & 4095) : 4096 + ((row - 16384) & 3);
                    const f32x4 cs = *(const f32x4*)(COS + pi * 32 + e0), sn = *(const f32x4*)(SIN + pi * 32 + e0);
                    float* fo = (typ == 1) ? kvdst(okp, oks, row) : (float*)nullptr;
#pragma unroll
                    for (int bj = 0; bj < 2; ++bj) {
                        const int hh = (u.pn & 1) * 4 + 2 * bj + (wc >> 1);
                        const f32x4 x1 = acc[ai][bj][m][0], x2 = acc[ai][bj][m][1];
                        const f32x4 o1 = x1 * cs - x2 * sn, o2 = x2 * cs + x1 * sn;
                        bf16_t* pb = dstb + (size_t)row * 512 + hh * 64 + e0;
                        u32x2 w1, w2; w1.x = cvt_pk_bf16(o1[0], o1[1]); w1.y = cvt_pk_bf16(o1[2], o1[3]); w2.x = cvt_pk_bf16(o2[0], o2[1]); w2.y = cvt_pk_bf16(o2[2], o2[3]);
                        *(u32x2*)pb = w1; *(u32x2*)(pb + 32) = w2;
                        if (fo) { *(f32x4*)(fo + hh * 64 + e0) = o1; *(f32x4*)(fo + hh * 64 + e0 + 32) = o2; }
                    }
                }
        } else {
#pragma unroll
            for (int ai = 0; ai < 2; ++ai)
#pragma unroll
                for (int m = 0; m < 4; ++m) {
                    const int row = row0 + ai * HALF + m * 16;
                    float* fo = (typ == 2) ? kvdst(ovp, ovs, row) : (float*)nullptr;
#pragma unroll
                    for (int bj = 0; bj < 2; ++bj)
#pragma unroll
                        for (int n = 0; n < 2; ++n) {
                            const int col = cbase + bj * HALF + wc * 32 + n * 16 + 4 * fq;
                            const f32x4 z = acc[ai][bj][m][n];
                            const size_t off = (size_t)row * 512 + col;
                            if (typ == 2) {
                                u32x2 w; w.x = cvt_pk_bf16(z[0], z[1]); w.y = cvt_pk_bf16(z[2], z[3]); *(u32x2*)(Vb + off) = w;
                                if (fo) *(f32x4*)(fo + col) = z;
                            } else if (typ == 3) {
                                f32x4 o; for (int i = 0; i < 4; ++i) o[i] = fsilu(z[i]); *(f32x4*)(HQ + off) = o;
                            } else if (typ == 4) {
                                const f32x4 lb = *(const f32x4*)(LB + col); f32x4 lf, kh;
                                for (int i = 0; i < 4; ++i) { const float sg = fsig(z[i]), sm = fsig(-z[i]); lf[i] = __logf(lb[i] + (1.0f - lb[i]) * sg); kh[i] = (1.0f - lb[i]) * sm; }
                                *(f32x4*)(LOGF + off) = lf; *(f32x4*)(KH + off) = kh;
                            } else if (typ == 5) {
                                *(f32x4*)(HI + off) = z;
                            } else {
                                f32x4 o; for (int i = 0; i < 4; ++i) o[i] = fsilu(z[i]); *(f32x4*)(HG + off) = o;
                            }
                        }
                }
        }
    }
};

template <class Epi, class Sched, bool ALIGN_EPI = false, bool SP2 = false>
__device__ __forceinline__ void gemm_phase(PG8_LAS unsigned char* lds, const Gemm g, const Sched& S, const Epi& E, int tid_in) {
    int tid_o = tid_in; asm volatile("" : "+v"(tid_o));
    const int tid = tid_o, wid = __builtin_amdgcn_readfirstlane(tid >> 6), lane = tid & 63, wr = wid >> 2, wc = wid & 3, fr = lane & 15, fq = lane >> 4;
    const int K = g.ld, nt = g.K / BK;
    unsigned voffA[2], voffB[2];
#pragma unroll
    for (int i = 0; i < 2; ++i) { int R, C; stage_rc(tid * 16 + i * 8192, R, C); const int Rb = Epi::PERM ? ((R & ~31) + perm32(R & 31)) : R;
        voffA[i] = (unsigned)(R * K + C) * 2u; voffB[i] = (unsigned)(Rb * K + C) * 2u; }
    const size_t kstep = (size_t)(BK * 2);
    const size_t hstep = (size_t)HALF * K * 2;
    const size_t tstep = 2 * hstep;
    const unsigned ldsw = (unsigned)wid * 1024u;
    const int aoff = lds_byte(wr * 64 + fr, fq * 8), boff = lds_byte(wc * 32 + fr, fq * 8);
#define PG8_SA(b, h) (((b) * 2 + (h)) * HTB)
#define PG8_SB(b, h) ((4 + (b) * 2 + (h)) * HTB)
#define PG8_STAGE(bufoff, gbase, voff) do { _Pragma("unroll") for (int _i = 0; _i < 2; ++_i) \
        __builtin_amdgcn_global_load_lds((const unsigned*)((const char*)(gbase) + (voff)[_i]), (PG8_LAS unsigned*)(lds + (bufoff) + ldsw + _i * 8192), 16, 0, 0); } while (0)
#define PG8_LDA(dst, b, h) do { _Pragma("unroll") for (int m = 0; m < 4; ++m) _Pragma("unroll") for (int k = 0; k < 2; ++k) dst[m][k] = *(const PG8_LAS bf16x8*)(lds + PG8_SA(b, h) + aoff + m * 2048 + k * 1024); } while (0)
#define PG8_LDB(dst, b, h) do { _Pragma("unroll") for (int n = 0; n < 2; ++n) _Pragma("unroll") for (int k = 0; k < 2; ++k) dst[n][k] = *(const PG8_LAS bf16x8*)(lds + PG8_SB(b, h) + boff + n * 2048 + k * 1024); } while (0)
#define PG8_MMA(ai, bj, At, Bt) do { __builtin_amdgcn_s_setprio(1); _Pragma("unroll") for (int m = 0; m < 4; ++m) _Pragma("unroll") for (int n = 0; n < 2; ++n) _Pragma("unroll") for (int k = 0; k < 2; ++k) \
        acc[ai][bj][m][n] = __builtin_amdgcn_mfma_f32_16x16x32_bf16(Bt[n][k], At[m][k], acc[ai][bj][m][n], 0, 0, 0); __builtin_amdgcn_s_setprio(0); } while (0)
#define PG8_WAIT_V(n) asm volatile("s_waitcnt vmcnt(" #n ")" ::: "memory")
#define PG8_WAIT_L(n) asm volatile("s_waitcnt lgkmcnt(" #n ")" ::: "memory")
#define PG8_BAR __builtin_amdgcn_s_barrier()
#define PG8_SCHED __builtin_amdgcn_sched_barrier(0)
    Unit cur, nxt; int ui = 0;
    if (!S.next(0, cur)) return;
    f32x4 acc[2][2][4][2];
#pragma unroll
    for (int a = 0; a < 2; ++a)
#pragma unroll
        for (int b = 0; b < 2; ++b)
#pragma unroll
            for (int m = 0; m < 4; ++m)
#pragma unroll
                for (int n = 0; n < 2; ++n) acc[a][b][m][n] = (f32x4){0.f, 0.f, 0.f, 0.f};
    bf16x8 At[4][2], B0[2][2], B1[2][2];
    const size_t ksb = (size_t)g.K * 2;
    const char* cA = (const char*)g.A + (size_t)cur.pm * tstep + (size_t)cur.ks * ksb; const char* cB = (const char*)g.Bt + (size_t)cur.pn * tstep + (size_t)cur.ks * ksb;
    S.a_ready(cur);
    if constexpr (SP2) {
        PG8_STAGE(PG8_SB(0, 0), cB, voffB); PG8_STAGE(PG8_SB(0, 1), cB + hstep, voffB); PG8_STAGE(PG8_SA(0, 0), cA, voffA); PG8_STAGE(PG8_SA(0, 1), cA + hstep, voffA);
        if (wr == 1) PG8_BAR;
        PG8_WAIT_V(2); PG8_BAR;
        PG8_STAGE(PG8_SB(1, 0), cB + kstep, voffB); PG8_STAGE(PG8_SA(1, 0), cA + kstep, voffA); PG8_STAGE(PG8_SB(1, 1), cB + hstep + kstep, voffB);
        PG8_WAIT_V(6); PG8_BAR;
    } else {
        PG8_STAGE(PG8_SB(0, 0), cB, voffB); PG8_STAGE(PG8_SA(0, 0), cA, voffA); PG8_STAGE(PG8_SB(0, 1), cB + hstep, voffB); PG8_STAGE(PG8_SA(0, 1), cA + hstep, voffA);
        if (wr == 1) PG8_BAR;
        PG8_WAIT_V(4); PG8_BAR;
        PG8_STAGE(PG8_SB(1, 0), cB + kstep, voffB); PG8_STAGE(PG8_SA(1, 0), cA + kstep, voffA); PG8_STAGE(PG8_SB(1, 1), cB + hstep + kstep, voffB);
        PG8_WAIT_V(6); PG8_BAR;
    }
    for (;;) {
        const bool has_next = S.next(ui + 1, nxt);
        const char* nA = has_next ? (const char*)g.A + (size_t)nxt.pm * tstep + (size_t)nxt.ks * ksb : cA; const char* nB = has_next ? (const char*)g.Bt + (size_t)nxt.pn * tstep + (size_t)nxt.ks * ksb : cB;
        for (int t = 0; t < nt; t += 2) {
            const bool last = (t == nt - 2);
            const char* a1 = cA + (size_t)(t + 1) * kstep;
            const char* a2 = last ? nA : cA + (size_t)(t + 2) * kstep; const char* b2 = last ? nB : cB + (size_t)(t + 2) * kstep;
            const char* a3 = a2 + kstep; const char* b3 = b2 + kstep;
            if (last && has_next) S.a_ready(nxt);
            if constexpr (SP2) {
            PG8_LDB(B0, 0, 0); PG8_LDB(B1, 0, 1); PG8_SCHED; PG8_LDA(At, 0, 0); PG8_STAGE(PG8_SA(1, 1), a1 + hstep, voffA);
            PG8_WAIT_V(8); PG8_WAIT_L(0); PG8_BAR; PG8_MMA(0, 0, At, B0); PG8_MMA(0, 1, At, B1); PG8_BAR; PG8_SCHED;
            PG8_LDA(At, 0, 1); PG8_STAGE(PG8_SB(0, 0), b2, voffB); PG8_STAGE(PG8_SB(0, 1), b2 + hstep, voffB); PG8_STAGE(PG8_SA(0, 0), a2, voffA);
            PG8_WAIT_V(8); PG8_WAIT_L(0); PG8_BAR; PG8_MMA(1, 0, At, B0); PG8_MMA(1, 1, At, B1); PG8_BAR; PG8_SCHED;
            PG8_LDB(B0, 1, 0); PG8_LDB(B1, 1, 1); PG8_SCHED; PG8_LDA(At, 1, 0); PG8_STAGE(PG8_SA(0, 1), a2 + hstep, voffA);
            PG8_WAIT_V(8); PG8_WAIT_L(0); PG8_BAR; PG8_MMA(0, 0, At, B0); PG8_MMA(0, 1, At, B1); PG8_BAR; PG8_SCHED;
            PG8_LDA(At, 1, 1); PG8_STAGE(PG8_SB(1, 0), b3, voffB); PG8_STAGE(PG8_SB(1, 1), b3 + hstep, voffB); PG8_STAGE(PG8_SA(1, 0), a3, voffA);
            PG8_WAIT_V(8); PG8_WAIT_L(0); PG8_BAR; PG8_MMA(1, 0, At, B0); PG8_MMA(1, 1, At, B1); PG8_BAR; PG8_SCHED;
            } else {
            PG8_LDB(B0, 0, 0); PG8_SCHED; PG8_LDA(At, 0, 0); PG8_STAGE(PG8_SA(1, 1), a1 + hstep, voffA);
            PG8_WAIT_L(8); PG8_BAR; PG8_WAIT_L(0); PG8_MMA(0, 0, At, B0); PG8_BAR; PG8_SCHED;
            PG8_LDB(B1, 0, 1); PG8_STAGE(PG8_SB(0, 0), b2, voffB);
            PG8_BAR; PG8_WAIT_L(0); PG8_MMA(0, 1, At, B1); PG8_BAR;
            PG8_LDA(At, 0, 1); PG8_STAGE(PG8_SA(0, 0), a2, voffA);
            PG8_BAR; PG8_WAIT_L(0); PG8_MMA(1, 0, At, B0); PG8_BAR; PG8_SCHED;
            PG8_STAGE(PG8_SB(0, 1), b2 + hstep, voffB);
            PG8_WAIT_V(6); PG8_BAR; PG8_MMA(1, 1, At, B1); PG8_BAR;
            PG8_LDB(B0, 1, 0); PG8_SCHED; PG8_LDA(At, 1, 0); PG8_STAGE(PG8_SA(0, 1), a2 + hstep, voffA);
            PG8_WAIT_L(8); PG8_BAR; PG8_WAIT_L(0); PG8_MMA(0, 0, At, B0); PG8_BAR; PG8_SCHED;
            PG8_LDB(B1, 1, 1); PG8_STAGE(PG8_SB(1, 0), b3, voffB);
            PG8_BAR; PG8_WAIT_L(0); PG8_MMA(0, 1, At, B1); PG8_BAR;
            PG8_LDA(At, 1, 1); PG8_STAGE(PG8_SA(1, 0), a3, voffA);
            PG8_BAR; PG8_WAIT_L(0); PG8_MMA(1, 0, At, B0); PG8_BAR; PG8_SCHED;
            PG8_STAGE(PG8_SB(1, 1), b3 + hstep, voffB);
            PG8_WAIT_V(6); PG8_BAR; PG8_MMA(1, 1, At, B1); PG8_BAR;
            }
        }
        if constexpr (ALIGN_EPI) { if (wr == 0) PG8_BAR; }
        if constexpr (!Epi::AFTER_DRAIN) { E(acc, cur, wr, wc, fr, fq); S.done(cur); }
        if (!has_next) break;
#pragma unroll
        for (int a = 0; a < 2; ++a)
#pragma unroll
            for (int b = 0; b < 2; ++b)
#pragma unroll
                for (int m = 0; m < 4; ++m)
#pragma unroll
                    for (int n = 0; n < 2; ++n) acc[a][b][m][n] = (f32x4){0.f, 0.f, 0.f, 0.f};
        cur = nxt; cA = nA; cB = nB; ++ui;
        if constexpr (ALIGN_EPI) { if (wr == 1) PG8_BAR; }
    }
    PG8_WAIT_V(0);
    if constexpr (!ALIGN_EPI) { if (wr == 0) PG8_BAR; }
    PG8_BAR;
    if constexpr (Epi::AFTER_DRAIN) { E.fused(acc, cur, wr, wc, fr, fq, lds, wid, lane); S.done(cur); }
#undef PG8_SA
#undef PG8_SB
#undef PG8_STAGE
#undef PG8_LDA
#undef PG8_LDB
#undef PG8_MMA
#undef PG8_WAIT_V
#undef PG8_WAIT_L
#undef PG8_BAR
#undef PG8_SCHED
}
}
#define GAS __attribute__((address_space(1)))
#define LAS __attribute__((address_space(3)))
typedef unsigned short bf16;
typedef unsigned v4u __attribute__((ext_vector_type(4)));
typedef float f32x4 __attribute__((ext_vector_type(4)));
typedef short bf16x8 __attribute__((ext_vector_type(8)));
typedef GAS unsigned gu32;
typedef GAS unsigned long long gu64;
#define RLX_AGENT __ATOMIC_RELAXED, __HIP_MEMORY_SCOPE_AGENT
#define LDS_WAIT() asm volatile("s_waitcnt lgkmcnt(0)" ::: "memory")
#define VM_WAIT() asm volatile("s_waitcnt vmcnt(0)" ::: "memory")
__device__ __forceinline__ unsigned long long rt() { return __builtin_amdgcn_s_memrealtime(); }
__device__ __forceinline__ unsigned f2bf(float f) { unsigned u = __builtin_bit_cast(unsigned, f); return (u + 0x7fffu + ((u >> 16) & 1u)) >> 16; }
__device__ __forceinline__ unsigned pk2(float lo, float hi) { return f2bf(lo) | (f2bf(hi) << 16); }

#define XB_TMO      128
#define XB_XCNT(j)  (256  + 64 * (j))
#define XB_XSUB(j)  (1280 + 64 * (j))
#define XB_XGEN(j)  (2304 + 64 * (j))
#define XB_TOP      3328
#define XB_TOPGEN   3392
#define XCD_BAR_WORDS 3456
#define XB_SPIN_CAP (1u << 18)

__device__ __forceinline__ unsigned xb_ld(unsigned* p)              { return __hip_atomic_load(p, __ATOMIC_RELAXED, __HIP_MEMORY_SCOPE_AGENT); }
__device__ __forceinline__ unsigned xb_add(unsigned* p, unsigned v) { return __hip_atomic_fetch_add(p, v, __ATOMIC_RELAXED, __HIP_MEMORY_SCOPE_AGENT); }
__device__ __forceinline__ unsigned xb_xcc_id() { return (unsigned)__builtin_amdgcn_s_getreg((3 << 11) | 20) & 0xFu; }
#define XB_SPIN(cond, bar) do { unsigned _sp = 0; while (cond) { __builtin_amdgcn_s_sleep(1); \
    if ((++_sp & 255u) == 0u) { if (xb_ld(&(bar)[XB_TMO])) break; if (_sp > XB_SPIN_CAP) { atomicAdd(&(bar)[XB_TMO], 1u); break; } } } } while (0)

struct XcdBarrier {
    unsigned* bar; unsigned x;
    volatile LAS unsigned* st;
};

__device__ __forceinline__ XcdBarrier xcd_barrier_post(unsigned* bar, volatile LAS unsigned* st) {
    XcdBarrier b; b.bar = bar; b.x = xb_xcc_id(); b.st = st;
    if (threadIdx.x == 0) (void)xb_add(&bar[XB_XCNT(b.x)], 1u);
    return b;
}
__device__ __forceinline__ void xcd_barrier_complete(unsigned* bar, unsigned x, unsigned& nloc, unsigned& nx) {
    const unsigned G = gridDim.x * gridDim.y * gridDim.z;
    unsigned sum, cnt, mine, sp = 0u;
    for (;;) {
        sum = 0u; cnt = 0u; mine = 0u;
#pragma unroll
        for (unsigned j = 0; j < 16; ++j) { const unsigned c = xb_ld(&bar[XB_XCNT(j)]); sum += c; cnt += (c > 0u) ? 1u : 0u; mine = (j == x) ? c : mine; }
        if (sum == G) break;
        __builtin_amdgcn_s_sleep(1);
        if ((++sp & 255u) == 0u) { if (xb_ld(&bar[XB_TMO])) break; if (sp > XB_SPIN_CAP) { atomicAdd(&bar[XB_TMO], 1u); break; } }
    }
    nloc = mine > 0u ? mine : 1u; nx = cnt > 0u ? cnt : 1u;
}

__device__ __forceinline__ void xcd_barrier(const XcdBarrier& b) {
    asm volatile("s_waitcnt vmcnt(0)" ::: "memory");
    __syncthreads();
    if (threadIdx.x == 0) {
        unsigned* bar = b.bar;
        __builtin_amdgcn_s_waitcnt(0);
        unsigned nloc = b.st[0], nx = b.st[1];
        if (nloc == 0u) { xcd_barrier_complete(bar, b.x, nloc, nx); b.st[0] = nloc; b.st[1] = nx; }
        const unsigned old = xb_add(&bar[XB_XSUB(b.x)], 1u);
        const unsigned gen = old / nloc;
        if (old + 1u == (gen + 1u) * nloc) {
            __builtin_amdgcn_fence(__ATOMIC_RELEASE, "agent");
            asm volatile("s_waitcnt vmcnt(0)" ::: "memory");
            const unsigned og = xb_add(&bar[XB_TOP], 1u);
            const unsigned tg = og / nx;
            if (og + 1u == (tg + 1u) * nx) xb_add(&bar[XB_TOPGEN], 1u);
            else XB_SPIN(xb_ld(&bar[XB_TOPGEN]) == tg, bar);
            __builtin_amdgcn_fence(__ATOMIC_ACQUIRE, "agent");
            xb_add(&bar[XB_XGEN(b.x)], 1u);
            asm volatile("s_waitcnt vmcnt(0)" ::: "memory");
        } else {
            XB_SPIN(xb_ld(&bar[XB_XGEN(b.x)]) == gen, bar);
            __builtin_amdgcn_fence(__ATOMIC_ACQUIRE, "agent");
            asm volatile("s_waitcnt vmcnt(0)" ::: "memory");
        }
    }
    __syncthreads();
}
constexpr int NWAVES = 8;
constexpr int D = 1024, MP = 16384, MS = 512, M = MP + MS, FF = 2816, NGU = 2 * FF, NIN = 3584, SEQ = 4096;
constexpr float LN_EPS = 1e-5f;
constexpr float DN_ALPHA = 1.189207115002721f;
constexpr size_t MiB = 1u << 20;
constexpr size_t WS_CTL = 0, CTL_ZERO_BYTES = 1 * MiB;
constexpr size_t WS_COS = 1 * MiB, WS_SIN = 1 * MiB + 640 * 1024, WS_LB = 1 * MiB + 1280 * 1024;
constexpr size_t WS_W1GU = 4 * MiB, WS_W1D = 15 * MiB, WS_WIN = 21 * MiB, WS_WOUT = 28 * MiB, WS_W2GU = 30 * MiB, WS_W2D = 41 * MiB;
constexpr size_t WS_XB = 48 * MiB, WS_X1B = 82 * MiB, WS_X2B = 116 * MiB, WS_H = 150 * MiB, WS_YPRE = 242 * MiB, WS_X1 = 308 * MiB, WS_X2 = 374 * MiB;
constexpr size_t WS_QB = 440 * MiB, WS_KB = 457 * MiB, WS_VB = 474 * MiB, WS_HQ = 491 * MiB, WS_LOGF = 524 * MiB, WS_KH = 557 * MiB, WS_HI = 590 * MiB, WS_HG = 623 * MiB;
constexpr size_t WS_CAT = 656 * MiB, WS_OPART = 689 * MiB, WS_LSE = 785 * MiB, WS_USEG = 787 * MiB, WS_DSEG = 803 * MiB, WS_DBG = 804 * MiB, WS_SLAB = 806 * MiB, WS_END = 830 * MiB;
static_assert(WS_W1GU + (size_t)NGU * D * 2 <= WS_W1D && WS_W1D + (size_t)D * FF * 2 <= WS_WIN && WS_WIN + (size_t)NIN * D * 2 <= WS_WOUT && WS_WOUT + (size_t)D * D * 2 <= WS_W2GU, "ws map (weights)");
static_assert(WS_XB + (size_t)M * D * 2 <= WS_X1B && WS_H + (size_t)M * FF * 2 <= WS_YPRE && WS_YPRE + (size_t)M * D * 4 <= WS_X1 && WS_X2 + (size_t)M * D * 4 <= WS_QB, "ws map (activations)");
static_assert(WS_QB + (size_t)M * 512 * 2 <= WS_KB && WS_HQ + (size_t)M * 512 * 4 <= WS_LOGF && WS_OPART + (size_t)3 * MP * 512 * 4 <= WS_LSE && WS_USEG + (size_t)256 * 65536 <= WS_DSEG, "ws map (mixer)");
constexpr int CW_BAR = 4096;
constexpr size_t O_YP = 0, O_YS = 16777216, O_KP = O_YS + 524288, O_VP = O_KP + 4194304, O_SP = O_VP + 4194304, O_KS = O_SP + 262144, O_VS = O_KS + 134217728, O_SS = O_VS + 134217728, O_END = O_SS + 8388608;
constexpr int RING_OFF = 0, RING_BYTES = 131072, LDSCTL_OFF = RING_BYTES, MISC_OFF = LDSCTL_OFF + 320, LDS_BYTES = 147456;

__constant__ float INV_FREQ[32] = {1.000000000e+00f, 7.498942614e-01f, 5.623413324e-01f, 4.216965139e-01f, 3.162277639e-01f, 2.371373773e-01f, 1.778279394e-01f, 1.333521307e-01f, 1.000000015e-01f, 7.498941571e-02f, 5.623413250e-02f, 4.216965288e-02f, 3.162277490e-02f, 2.371373773e-02f, 1.778279431e-02f, 1.333521493e-02f, 9.999999776e-03f, 7.498941850e-03f, 5.623413250e-03f, 4.216964822e-03f, 3.162277630e-03f, 2.371373586e-03f, 1.778279431e-03f, 1.333521446e-03f, 1.000000047e-03f, 7.498942432e-04f, 5.623413017e-04f, 4.216965172e-04f, 3.162277571e-04f, 2.371373703e-04f, 1.778279402e-04f, 1.333521504e-04f};

typedef unsigned u32x2 __attribute__((ext_vector_type(2)));
typedef unsigned short u16;
struct Ctx {
    LAS unsigned char* lds;
    int tid, lane, wave, G, bid;
    const float *xp, *xs, *ck, *cv, *st0, *w1g, *w1u, *w1d, *ln1g, *ln1b, *win, *hlb, *hng, *wout, *ln2g, *ln2b, *w2g, *w2u, *w2d, *ln3g, *ln3b;
    float* out; unsigned char* ws;
    __device__ __forceinline__ bf16* W1gu() const { return (bf16*)(ws + WS_W1GU); }
    __device__ __forceinline__ bf16* W1d() const { return (bf16*)(ws + WS_W1D); }
    __device__ __forceinline__ bf16* Win() const { return (bf16*)(ws + WS_WIN); }
    __device__ __forceinline__ bf16* Wout() const { return (bf16*)(ws + WS_WOUT); }
    __device__ __forceinline__ bf16* W2gu() const { return (bf16*)(ws + WS_W2GU); }
    __device__ __forceinline__ bf16* W2d() const { return (bf16*)(ws + WS_W2D); }
    __device__ __forceinline__ bf16* Xb() const { return (bf16*)(ws + WS_XB); }
    __device__ __forceinline__ bf16* X1b() const { return (bf16*)(ws + WS_X1B); }
    __device__ __forceinline__ bf16* X2b() const { return (bf16*)(ws + WS_X2B); }
    __device__ __forceinline__ bf16* Hb() const { return (bf16*)(ws + WS_H); }
    __device__ __forceinline__ bf16* Qb() const { return (bf16*)(ws + WS_QB); }
    __device__ __forceinline__ bf16* Kb() const { return (bf16*)(ws + WS_KB); }
    __device__ __forceinline__ bf16* Vb() const { return (bf16*)(ws + WS_VB); }
    __device__ __forceinline__ bf16* Cat() const { return (bf16*)(ws + WS_CAT); }
    __device__ __forceinline__ float* Ypre() const { return (float*)(ws + WS_YPRE); }
    __device__ __forceinline__ float* X1() const { return (float*)(ws + WS_X1); }
    __device__ __forceinline__ float* X2() const { return (float*)(ws + WS_X2); }
    __device__ __forceinline__ float* HQ() const { return (float*)(ws + WS_HQ); }
    __device__ __forceinline__ float* LOGF() const { return (float*)(ws + WS_LOGF); }
    __device__ __forceinline__ float* KH() const { return (float*)(ws + WS_KH); }
    __device__ __forceinline__ float* HI() const { return (float*)(ws + WS_HI); }
    __device__ __forceinline__ float* HG() const { return (float*)(ws + WS_HG); }
    __device__ __forceinline__ float* COS() const { return (float*)(ws + WS_COS); }
    __device__ __forceinline__ float* SIN() const { return (float*)(ws + WS_SIN); }
    __device__ __forceinline__ float* LB() const { return (float*)(ws + WS_LB); }
    __device__ __forceinline__ float* Opart() const { return (float*)(ws + WS_OPART); }
    __device__ __forceinline__ float* Lse() const { return (float*)(ws + WS_LSE); }
    __device__ __forceinline__ float* Useg() const { return (float*)(ws + WS_USEG); }
    __device__ __forceinline__ float* Dseg() const { return (float*)(ws + WS_DSEG); }
    __device__ __forceinline__ float* Slab() const { return (float*)(ws + WS_SLAB); }
};
__device__ __forceinline__ float wave_sum(float v) {
#pragma unroll
    for (int o = 1; o < 64; o <<= 1) v += __shfl_xor(v, o);
    return v;
}
template <int CTRL> __device__ __forceinline__ float dppf(float v) { return __builtin_bit_cast(float, __builtin_amdgcn_update_dpp(0, __builtin_bit_cast(int, v), CTRL, 0xf, 0xf, true)); }
__device__ __forceinline__ float row16_sum(float v) { v += dppf<0x128>(v); v += dppf<0x124>(v); v += dppf<0x122>(v); v += dppf<0x121>(v); return v; }
__device__ __forceinline__ float bf2f(unsigned h) { return __builtin_bit_cast(float, h << 16); }

struct RmNat { __device__ __forceinline__ int operator()(int c) const { return c; } };
struct RmGate { __device__ __forceinline__ int operator()(int c) const { return 256 * (c >> 7) + (c & 127); } };
struct RmUp { __device__ __forceinline__ int operator()(int c) const { return 256 * (c >> 7) + 128 + (c & 127); } };
struct RmWin { __device__ __forceinline__ int operator()(int c) const { if (c >= 1024) return c; const int j = c & 63; return (c & ~63) | (j & 15) | (((j >> 4) & 1) << 5) | (((j >> 5) & 1) << 4); } };
template <class RM>
__device__ __forceinline__ void p0_transpose_item(const float* W, int K, int N, bf16* WT, RM rm, LAS float* scr, int item, int lane) {
    const int nblk = N / 32, kb = item / nblk, nb = item % nblk, k0 = 64 * kb, n0 = 32 * nb;
#pragma unroll 8
    for (int i = 0; i < 32; ++i) { const int kk = 2 * i + (lane >> 5); scr[kk * 33 + (lane & 31)] = W[(size_t)(k0 + kk) * N + n0 + (lane & 31)]; }
    LDS_WAIT(); asm volatile("" ::: "memory");
    const int c = lane & 7;
#pragma unroll
    for (int j = 0; j < 4; ++j) { const int n = (lane >> 3) + 8 * j; const LAS float* s = scr + (8 * c) * 33 + n;
        v4u o; o.x = pk2(s[0 * 33], s[1 * 33]); o.y = pk2(s[2 * 33], s[3 * 33]); o.z = pk2(s[4 * 33], s[5 * 33]); o.w = pk2(s[6 * 33], s[7 * 33]);
        *(GAS v4u*)(WT + (size_t)rm(n0 + n) * K + k0 + 8 * c) = o; }
    LDS_WAIT(); asm volatile("" ::: "memory");
}
__device__ __forceinline__ void p0_prologue(const Ctx& F) {
    LAS float* scr = (LAS float*)(F.lds + RING_OFF + F.wave * 16384);
    const int gw = F.bid * NWAVES + F.wave, NGW = F.G * NWAVES;
    constexpr int I_G = (D / 64) * (FF / 32), I_D = (FF / 64) * (D / 32), I_IN = (D / 64) * (NIN / 32), I_O = (D / 64) * (D / 32);
    constexpr int NITEMS = 6 * I_G + I_IN + I_O; static_assert(I_G == I_D, "item counts");
    for (int it = gw; it < NITEMS; it += NGW) {
        int r = it;
        if (r < I_G) { p0_transpose_item(F.w1g, D, FF, F.W1gu(), RmGate(), scr, r, F.lane); continue; } r -= I_G;
        if (r < I_G) { p0_transpose_item(F.w1u, D, FF, F.W1gu(), RmUp(), scr, r, F.lane); continue; } r -= I_G;
        if (r < I_D) { p0_transpose_item(F.w1d, FF, D, F.W1d(), RmNat(), scr, r, F.lane); continue; } r -= I_D;
        if (r < I_G) { p0_transpose_item(F.w2g, D, FF, F.W2gu(), RmGate(), scr, r, F.lane); continue; } r -= I_G;
        if (r < I_G) { p0_transpose_item(F.w2u, D, FF, F.W2gu(), RmUp(), scr, r, F.lane); continue; } r -= I_G;
        if (r < I_D) { p0_transpose_item(F.w2d, FF, D, F.W2d(), RmNat(), scr, r, F.lane); continue; } r -= I_D;
        if (r < I_IN) { p0_transpose_item(F.win, D, NIN, F.Win(), RmWin(), scr, r, F.lane); continue; } r -= I_IN;
        p0_transpose_item(F.wout, D, D, F.Wout(), RmNat(), scr, r, F.lane);
    }
    for (int m = gw; m < M; m += NGW) {
        const float* xr = (m < MP) ? F.xp + (size_t)m * D : F.xs + (size_t)(m - MP) * D;
        const GAS f32x4* xv = (const GAS f32x4*)xr + F.lane; GAS unsigned long long* o8 = (GAS unsigned long long*)(F.Xb() + (size_t)m * D) + F.lane;
#pragma unroll
        for (int j = 0; j < 4; ++j) { const f32x4 v = xv[64 * j]; o8[64 * j] = (unsigned long long)pk2(v.x, v.y) | ((unsigned long long)pk2(v.z, v.w) << 32); }
    }
    for (int idx = F.bid * 512 + F.tid; idx < 4100 * 32; idx += F.G * 512) {
        const int pi = idx >> 5, i = idx & 31; const int pos = pi < 4096 ? pi : 8192 + (pi - 4096);
        const float ang = (float)pos * INV_FREQ[i];
        double rev = (double)ang * 0.15915494309189535; rev -= __builtin_rint(rev);
        const float rf = (float)rev;
        F.COS()[idx] = __builtin_amdgcn_cosf(rf); F.SIN()[idx] = __builtin_amdgcn_sinf(rf);
    }
    if (F.bid == 0) { const int c = F.tid; const float a0 = F.hlb[c], a1 = F.hlb[512 + c]; const float mx = fmaxf(a0, a1); const float e0 = __expf(a0 - mx), e1 = __expf(a1 - mx); F.LB()[c] = e0 / (e0 + e1); }
    if (F.G != 256) {
        constexpr size_t PER_B = (size_t)2044 * 512 / 4;
        const size_t nth = (size_t)F.G * 512;
        for (size_t i = (size_t)F.bid * 512 + F.tid; i < 128 * PER_B; i += nth) {
            const size_t b = i / PER_B, r = i - b * PER_B;
            const f32x4 a = __builtin_nontemporal_load((const f32x4*)(F.ck + b * 1048576 + 2048) + r);
            const f32x4 c = __builtin_nontemporal_load((const f32x4*)(F.cv + b * 1048576 + 2048) + r);
            __builtin_nontemporal_store(a, (f32x4*)(F.out + O_KS + b * 1048576) + r);
            __builtin_nontemporal_store(c, (f32x4*)(F.out + O_VS + b * 1048576) + r);
        }
    }
}
__device__ __forceinline__ void ln_rows(const Ctx& F, const float* pre, const float* gam, const float* bet, float* outf, bf16* outb, const float* resS, int nsp, float scale) {
    const int gw = F.bid * NWAVES + F.wave, NGW = F.G * NWAVES;
    f32x4 gv[4], bv[4];
#pragma unroll
    for (int j = 0; j < 4; ++j) { gv[j] = ((const f32x4*)gam)[F.lane + 64 * j]; bv[j] = ((const f32x4*)bet)[F.lane + 64 * j]; }
    for (int m = gw; m < M; m += NGW) {
        const f32x4* xr = (const f32x4*)(pre + (size_t)m * D) + F.lane;
        f32x4 v[4]; float s = 0.f;
        if (m < MP) {
#pragma unroll
            for (int j = 0; j < 4; ++j) v[j] = xr[64 * j];
        } else {
            const f32x4* rr = (const f32x4*)(resS + (size_t)(m - MP) * D) + F.lane;
#pragma unroll
            for (int j = 0; j < 4; ++j) v[j] = (f32x4){0.f, 0.f, 0.f, 0.f};
            for (int sp = 0; sp < nsp; ++sp) { const f32x4* sl = (const f32x4*)(F.Slab() + ((size_t)sp * MS + (m - MP)) * D) + F.lane;
#pragma unroll
                for (int j = 0; j < 4; ++j) v[j] += sl[64 * j]; }
#pragma unroll
            for (int j = 0; j < 4; ++j) v[j] = rr[64 * j] * DN_ALPHA + v[j] * scale;
        }
#pragma unroll
        for (int j = 0; j < 4; ++j) s += (v[j].x + v[j].y) + (v[j].z + v[j].w);
        const float mean = wave_sum(s) * (1.f / D); float s2 = 0.f;
#pragma unroll
        for (int j = 0; j < 4; ++j) { v[j] = v[j] - mean; s2 += (v[j].x * v[j].x + v[j].y * v[j].y) + (v[j].z * v[j].z + v[j].w * v[j].w); }
        const float rstd = 1.f / sqrtf(wave_sum(s2) * (1.f / D) + LN_EPS);
#pragma unroll
        for (int j = 0; j < 4; ++j) { const f32x4 y = v[j] * rstd * gv[j] + bv[j];
            ((f32x4*)(outf + (size_t)m * D))[F.lane + 64 * j] = y;
            if (outb) ((unsigned long long*)(outb + (size_t)m * D))[F.lane + 64 * j] = (unsigned long long)pk2(y.x, y.y) | ((unsigned long long)pk2(y.z, y.w) << 32); }
    }
}
typedef float f32x4v __attribute__((ext_vector_type(4)));
#define MFMA16(a, b, c) __builtin_amdgcn_mfma_f32_16x16x32_bf16((a), (b), (c), 0, 0, 0)
__device__ __forceinline__ bf16x8 pack8(const f32x4 a, const f32x4 b) {
    v4u w; w.x = pk2(a[0], a[1]); w.y = pk2(a[2], a[3]); w.z = pk2(b[0], b[1]); w.w = pk2(b[2], b[3]); return __builtin_bit_cast(bf16x8, w);
}
__device__ __forceinline__ bf16x8 join8(const u32x2 lo, const u32x2 hi) { v4u w; w.x = lo.x; w.y = lo.y; w.z = hi.x; w.w = hi.y; return __builtin_bit_cast(bf16x8, w); }

__device__ __forceinline__ void attn_prompt_unit(const Ctx& F, int u) {
    LAS unsigned char* L = F.lds;
    const int tid = F.tid, lane = F.lane, w = F.wave;
    const int bh = u / 96, rem = u - bh * 96, di = rem >> 5, x = rem & 31;
    const int b = bh >> 3, h = bh & 7, dsh = 2 * di, nbsh = 5 - dsh;
    const int r = x >> nbsh, qb = x & ((1 << nbsh) - 1);
    constexpr int KS_STRIDE = 144, VT_OFF = 256 * 144, VT_STRIDE = 528;
    {
        const int key = tid >> 1, half = tid & 1, isub = 128 * (qb - 1) + key;
        v4u kv[4], vv[4];
        if (isub >= 0) {
            const size_t row = (size_t)b * SEQ + r + ((size_t)isub << dsh);
            const v4u* kp = (const v4u*)(F.Kb() + row * 512 + h * 64 + 32 * half);
            const v4u* vp = (const v4u*)(F.Vb() + row * 512 + h * 64 + 32 * half);
#pragma unroll
            for (int i = 0; i < 4; ++i) { kv[i] = kp[i]; vv[i] = vp[i]; }
        } else {
#pragma unroll
            for (int i = 0; i < 4; ++i) { kv[i] = (v4u){0u, 0u, 0u, 0u}; vv[i] = (v4u){0u, 0u, 0u, 0u}; }
        }
#pragma unroll
        for (int i = 0; i < 4; ++i) *(LAS v4u*)(L + key * KS_STRIDE + (32 * half + 8 * i) * 2) = kv[i];
#pragma unroll
        for (int i = 0; i < 4; ++i)
#pragma unroll
            for (int c = 0; c < 4; ++c) { const unsigned wd = vv[i][c]; const int e = 32 * half + 8 * i + 2 * c;
                *(LAS u16*)(L + VT_OFF + e * VT_STRIDE + key * 2) = (u16)(wd & 0xffffu);
                *(LAS u16*)(L + VT_OFF + (e + 1) * VT_STRIDE + key * 2) = (u16)(wd >> 16); }
    }
    __syncthreads();
    const int q = lane & 15, g = lane >> 4;
    const int iq = 128 * qb + 16 * w + q;
    const size_t qrow = (size_t)b * SEQ + r + ((size_t)iq << dsh);
    const bf16x8 qf0 = *(const bf16x8*)(F.Qb() + qrow * 512 + h * 64 + 8 * g), qf1 = *(const bf16x8*)(F.Qb() + qrow * 512 + h * 64 + 32 + 8 * g);
    f32x4 s[9];
#pragma unroll
    for (int kt = 0; kt < 9; ++kt) {
        const int key = 16 * (w + kt) + q;
        const bf16x8 a0 = *(const LAS bf16x8*)(L + key * KS_STRIDE + (8 * g) * 2), a1 = *(const LAS bf16x8*)(L + key * KS_STRIDE + (32 + 8 * g) * 2);
        f32x4 acc = (f32x4){0.f, 0.f, 0.f, 0.f};
        acc = MFMA16(a0, qf0, acc); acc = MFMA16(a1, qf1, acc); s[kt] = acc;
    }
    float mx = -INFINITY;
#pragma unroll
    for (int kt = 0; kt < 9; ++kt)
#pragma unroll
        for (int rg = 0; rg < 4; ++rg) { const int cc = 16 * kt + 4 * g + rg; const bool ok = (cc >= q) && (cc <= q + 128) && (qb > 0 || 16 * w + cc >= 128);
            const float v = ok ? s[kt][rg] * 0.125f : -INFINITY; s[kt][rg] = v; mx = fmaxf(mx, v); }
    mx = fmaxf(mx, __shfl_xor(mx, 16)); mx = fmaxf(mx, __shfl_xor(mx, 32));
    float lsum = 0.f;
#pragma unroll
    for (int kt = 0; kt < 9; ++kt)
#pragma unroll
        for (int rg = 0; rg < 4; ++rg) { const float p = __expf(s[kt][rg] - mx); s[kt][rg] = p; lsum += p; }
    lsum += __shfl_xor(lsum, 16); lsum += __shfl_xor(lsum, 32);
    f32x4 o[4];
#pragma unroll
    for (int et = 0; et < 4; ++et) o[et] = (f32x4){0.f, 0.f, 0.f, 0.f};
    const f32x4 zero4 = (f32x4){0.f, 0.f, 0.f, 0.f};
#pragma unroll
    for (int p = 0; p < 5; ++p) {
        const bf16x8 pa = pack8(s[2 * p], p < 4 ? s[2 * p + 1] : zero4);
#pragma unroll
        for (int et = 0; et < 4; ++et) {
            const LAS unsigned char* vb = L + VT_OFF + (16 * et + q) * VT_STRIDE + (16 * w + 32 * p + 4 * g) * 2;
            const u32x2 lo = *(const LAS u32x2*)vb; u32x2 hi = (u32x2){0u, 0u}; if (p < 4) hi = *(const LAS u32x2*)(vb + 32);
            o[et] = MFMA16(pa, join8(lo, hi), o[et]);
        }
    }
#pragma unroll
    for (int rg = 0; rg < 4; ++rg) {
        const float lq = __shfl(lsum, 4 * g + rg), mq = __shfl(mx, 4 * g + rg);
        const int iq2 = 128 * qb + 16 * w + 4 * g + rg;
        const size_t row = (size_t)b * SEQ + r + ((size_t)iq2 << dsh);
        const float inv = 1.0f / lq;
        float* op = F.Opart() + ((size_t)di * MP + row) * 512 + h * 64 + q;
#pragma unroll
        for (int et = 0; et < 4; ++et) op[16 * et] = o[et][rg] * inv;
        if (q == 0) F.Lse()[((size_t)di * MP + row) * 8 + h] = mq + __logf(lq);
    }
    __syncthreads();
}
__device__ __forceinline__ void attn_combine_rows(const Ctx& F) {
    const int gw = F.bid * NWAVES + F.wave, NGW = F.G * NWAVES, lane = F.lane, h = lane >> 3;
    for (int m = gw; m < MP; m += NGW) {
        float ls[3], wt[3];
#pragma unroll
        for (int i = 0; i < 3; ++i) ls[i] = F.Lse()[((size_t)i * MP + m) * 8 + h];
        const float mxl = fmaxf(ls[0], fmaxf(ls[1], ls[2])); float den = 0.f;
#pragma unroll
        for (int i = 0; i < 3; ++i) { wt[i] = __expf(ls[i] - mxl); den += wt[i]; }
        const float rden = 1.0f / den;
        f32x4 a0 = (f32x4){0.f, 0.f, 0.f, 0.f}, a1 = a0;
#pragma unroll
        for (int i = 0; i < 3; ++i) { const f32x4* p = (const f32x4*)(F.Opart() + ((size_t)i * MP + m) * 512 + lane * 8); a0 += p[0] * (wt[i] * rden); a1 += p[1] * (wt[i] * rden); }
        v4u o; o.x = pk2(a0[0], a0[1]); o.y = pk2(a0[2], a0[3]); o.z = pk2(a1[0], a1[1]); o.w = pk2(a1[2], a1[3]);
        *(v4u*)(F.Cat() + (size_t)m * 1024 + lane * 8) = o;
    }
}
__device__ __forceinline__ int samp_rho_row(int rho, int rot) { rho += rot; rho = rho >= 900 ? rho - 900 : rho; return rho < 384 ? ((rho >> 2) << 4) + (rho & 3) : 1152 + rho; }
__device__ __forceinline__ const f32x4* samp_rowp(const float* cache, const float* onew, int bd, int r, int hf, int lane) {
    const float* p = r < 2048 ? cache + (size_t)(bd * 2048 + r) * 512 : onew + (size_t)(bd * 2048 + 2044 + (r - 2048)) * 512;
    return (const f32x4*)(p + hf * 256) + lane;
}
__device__ __forceinline__ void attn_sample_unit(const Ctx& F, int u) {
    const int bd = u >> 1, hf = u & 1, tid = F.tid, lane = F.lane, w = F.wave, hl = lane >> 4, li = lane & 15;
    LAS float* SC = (LAS float*)F.lds;
    LAS float* ST = (LAS float*)(F.lds + 25344);
    LAS float* CF = (LAS float*)(F.lds + 25728);
    LAS float* RED = (LAS float*)(F.lds + 32768);
    const float* okn = F.out + O_KS; const float* ovn = F.out + O_VS;
    const int rot = (u * 29) % 900;
    f32x4 qv[4];
#pragma unroll
    for (int s = 0; s < 4; ++s) { const u32x2 qw = *(const u32x2*)(F.Qb() + (size_t)(MP + bd * 4 + s) * 512 + (4 * hf + hl) * 64 + 4 * li);
        qv[s] = (f32x4){bf2f(qw.x & 0xffffu), bf2f(qw.x >> 16), bf2f(qw.y & 0xffffu), bf2f(qw.y >> 16)} * 0.125f; }
    for (int i0 = 0; i0 < 113; i0 += 8) {
        f32x4 kk[8];
#pragma unroll
        for (int j = 0; j < 8; ++j) { const int rho = w + 8 * (i0 + j); kk[j] = __builtin_nontemporal_load(samp_rowp(F.ck, okn, bd, samp_rho_row(rho < 900 ? rho : 899, rot), hf, lane)); }
#pragma unroll
        for (int j = 0; j < 8; ++j) { const int rho = w + 8 * (i0 + j);
            if (rho < 900) { const int r = samp_rho_row(rho, rot);
#pragma unroll
                for (int s = 0; s < 4; ++s) {
                    float d = (qv[s][0] * kk[j][0] + qv[s][1] * kk[j][1]) + (qv[s][2] * kk[j][2] + qv[s][3] * kk[j][3]);
                    d = row16_sum(d);
                    const int t = 2048 + s - r;
                    if (t >= 0 && li == 0) { LAS float* base = SC + ((hl * 4 + s) * 3) * 132;
                        if (t <= 128) base[t] = d;
                        if ((t & 3) == 0 && (t >> 2) <= 128) base[132 + (t >> 2)] = d;
                        if ((t & 15) == 0 && (t >> 4) <= 128) base[264 + (t >> 4)] = d; }
                } } }
    }
    __syncthreads();
    for (int c = w; c < 48; c += 8) {
        LAS float* base = SC + c * 132;
        const float v0 = base[lane], v1 = base[64 + lane], v2 = (lane == 0) ? base[128] : -INFINITY;
        float mx = fmaxf(v0, fmaxf(v1, v2));
#pragma unroll
        for (int o = 1; o < 64; o <<= 1) mx = fmaxf(mx, __shfl_xor(mx, o));
        const float p0 = __expf(v0 - mx), p1 = __expf(v1 - mx), p2 = (lane == 0) ? __expf(v2 - mx) : 0.f;
        const float l = wave_sum(p0 + p1 + p2);
        base[lane] = p0; base[64 + lane] = p1; if (lane == 0) { base[128] = p2; ST[2 * c] = mx; ST[2 * c + 1] = l; }
    }
    __syncthreads();
    if (tid < 16) {
        float ls[3], cf[3], mxl = -INFINITY, den = 0.f;
#pragma unroll
        for (int i = 0; i < 3; ++i) { ls[i] = ST[2 * (tid * 3 + i)] + __logf(ST[2 * (tid * 3 + i) + 1]); mxl = fmaxf(mxl, ls[i]); }
#pragma unroll
        for (int i = 0; i < 3; ++i) { cf[i] = __expf(ls[i] - mxl); den += cf[i]; }
#pragma unroll
        for (int i = 0; i < 3; ++i) CF[tid * 3 + i] = cf[i] / (den * ST[2 * (tid * 3 + i) + 1]);
    }
    __syncthreads();
    for (int c = w; c < 48; c += 8) { LAS float* base = SC + c * 132; const float cf = CF[c]; base[lane] *= cf; base[64 + lane] *= cf; if (lane == 0) base[128] *= cf; }
    __syncthreads();
    f32x4 acc[4];
#pragma unroll
    for (int s = 0; s < 4; ++s) acc[s] = (f32x4){0.f, 0.f, 0.f, 0.f};
    for (int i0 = 0; i0 < 113; i0 += 8) {
        f32x4 vv[8];
#pragma unroll
        for (int j = 0; j < 8; ++j) { const int rho = w + 8 * (i0 + j); vv[j] = __builtin_nontemporal_load(samp_rowp(F.cv, ovn, bd, samp_rho_row(rho < 900 ? rho : 899, rot), hf, lane)); }
#pragma unroll
        for (int j = 0; j < 8; ++j) { const int rho = w + 8 * (i0 + j);
            if (rho < 900) { const int r = samp_rho_row(rho, rot);
#pragma unroll
                for (int s = 0; s < 4; ++s) { const int t = 2048 + s - r, tc = t < 0 ? 0 : t;
                    const LAS float* base = SC + ((hl * 4 + s) * 3) * 132;
                    const int i0 = tc > 128 ? 128 : tc, i1 = (tc >> 2) > 128 ? 128 : (tc >> 2), i2 = (tc >> 4) > 128 ? 128 : (tc >> 4);
                    const float m0 = (t >= 0 && t <= 128) ? 1.f : 0.f, m1 = (t >= 0 && (t & 3) == 0 && (t >> 2) <= 128) ? 1.f : 0.f, m2 = (t >= 0 && (t & 15) == 0 && (t >> 4) <= 128) ? 1.f : 0.f;
                    const float ws = base[i0] * m0 + base[132 + i1] * m1 + base[264 + i2] * m2;
                    acc[s] += vv[j] * ws; } } }
    }
#pragma unroll
    for (int s = 0; s < 4; ++s) *(LAS f32x4*)(RED + ((w * 4 + s) * 256 + lane * 4)) = acc[s];
    __syncthreads();
    for (int o = tid; o < 1024; o += 512) { const int s = o >> 8, col = o & 255; float a = 0.f;
#pragma unroll
        for (int w2 = 0; w2 < 8; ++w2) a += RED[(w2 * 4 + s) * 256 + col];
        F.Cat()[(size_t)(MP + bd * 4 + s) * 1024 + hf * 256 + col] = (bf16)f2bf(a); }
    __syncthreads();
}
__device__ __forceinline__ void hgrn_sample_unit(const Ctx& F, int u) {
    const int bd = u >> 2, hh = u & 3, tid = F.tid, lane = F.lane, w = F.wave;
    LAS float* part = (LAS float*)F.lds;
    LAS float* ssq = (LAS float*)(F.lds + 32768);
    const int v4 = tid & 31, kq = tid >> 5;
    const float* sp = F.st0 + ((size_t)u * 128 + 8 * kq) * 128 + 4 * v4;
    float* so = F.out + O_SS + ((size_t)u * 128 + 8 * kq) * 128 + 4 * v4;
    f32x4 S[8];
#pragma unroll
    for (int i = 0; i < 8; ++i) S[i] = *(const f32x4*)(sp + (size_t)i * 128);
#pragma unroll
    for (int s = 0; s < 4; ++s) {
        const size_t base = (size_t)(MP + bd * 4 + s) * 512 + hh * 128;
        const f32x4 kh0 = *(const f32x4*)(F.KH() + base + 8 * kq), kh1 = *(const f32x4*)(F.KH() + base + 8 * kq + 4);
        const f32x4 q0 = *(const f32x4*)(F.HQ() + base + 8 * kq), q1 = *(const f32x4*)(F.HQ() + base + 8 * kq + 4);
        const f32x4 iv = *(const f32x4*)(F.HI() + base + 4 * v4);
        f32x4 po = (f32x4){0.f, 0.f, 0.f, 0.f};
#pragma unroll
        for (int i = 0; i < 8; ++i) { const float kh = i < 4 ? kh0[i & 3] : kh1[i & 3], qq = i < 4 ? q0[i & 3] : q1[i & 3];
            S[i] = S[i] * (1.0f - kh) + iv * kh; po += S[i] * qq; }
        *(LAS f32x4*)(part + (s * 16 + kq) * 128 + 4 * v4) = po;
    }
#pragma unroll
    for (int i = 0; i < 8; ++i) *(f32x4*)(so + (size_t)i * 128) = S[i];
    __syncthreads();
    const int s = tid >> 7, v = tid & 127; float o = 0.f;
#pragma unroll
    for (int k2 = 0; k2 < 16; ++k2) o += part[(s * 16 + k2) * 128 + v];
    const float sq = wave_sum(o * o);
    if (lane == 0) ssq[w] = sq;
    __syncthreads();
    const float tot = ssq[2 * s] + ssq[2 * s + 1];
    const float rstd = 1.0f / sqrtf(tot * (1.0f / 128.0f) + LN_EPS);
    const size_t row = (size_t)(MP + bd * 4 + s); const int col = hh * 128 + v;
    F.Cat()[row * 1024 + 512 + col] = (bf16)f2bf(o * rstd * F.hng[col] * F.HG()[row * 512 + col]);
    __syncthreads();
}
constexpr int HG_QD = 0, HG_KD = 8704, HG_KET = 17408, HG_VT = 27648, HG_DEC = 37888, HG_BUF = 38400, HG_SSQ = 2 * HG_BUF;
struct HgIn { float lf[8], kh[8], q[8], vi[8]; };
template <bool FULL>
__device__ __forceinline__ void hgrn_load(const Ctx& F, HgIn& r, int b, int hh, int t0) {
    const int k = F.tid >> 2, tq = F.tid & 3;
    const size_t rbase = ((size_t)b * SEQ + t0 + 8 * tq) * 512 + hh * 128 + k;
    const float* pl = F.LOGF() + rbase; const float* pk = F.KH() + rbase; const float* pq = F.HQ() + rbase; const float* pv = F.HI() + rbase;
#pragma unroll
    for (int i = 0; i < 8; ++i) { r.lf[i] = pl[(size_t)i * 512]; r.kh[i] = pk[(size_t)i * 512]; r.vi[i] = pv[(size_t)i * 512]; if (FULL) r.q[i] = pq[(size_t)i * 512]; }
}
template <bool FULL>
__device__ __forceinline__ float hgrn_stage(const Ctx& F, const HgIn& r, int par) {
    LAS unsigned char* L = F.lds + par * HG_BUF; const int k = F.tid >> 2, tq = F.tid & 3;
    float cum[8];
    cum[0] = r.lf[0];
#pragma unroll
    for (int i = 1; i < 8; ++i) cum[i] = cum[i - 1] + r.lf[i];
    const float c7 = cum[7];
    const float v0 = dppf<0x00>(c7), v1 = dppf<0x55>(c7), v2 = dppf<0xAA>(c7), v3 = dppf<0xFF>(c7);
    const float tot = (v0 + v1) + (v2 + v3);
    const float off = (tq > 0 ? v0 : 0.f) + (tq > 1 ? v1 : 0.f) + (tq > 2 ? v2 : 0.f);
    float ke[8];
#pragma unroll
    for (int i = 0; i < 8; ++i) { const float c = cum[i] + off; const int t = 8 * tq + i;
        if (FULL) { *(LAS u16*)(L + HG_QD + t * 272 + k * 2) = (u16)f2bf(r.q[i] * __expf(c)); *(LAS u16*)(L + HG_KD + t * 272 + k * 2) = (u16)f2bf(r.kh[i] * __expf(-c)); }
        ke[i] = r.kh[i] * __expf(tot - c); }
    v4u wk, wv; wk.x = pk2(ke[0], ke[1]); wk.y = pk2(ke[2], ke[3]); wk.z = pk2(ke[4], ke[5]); wk.w = pk2(ke[6], ke[7]);
    wv.x = pk2(r.vi[0], r.vi[1]); wv.y = pk2(r.vi[2], r.vi[3]); wv.z = pk2(r.vi[4], r.vi[5]); wv.w = pk2(r.vi[6], r.vi[7]);
    *(LAS v4u*)(L + HG_KET + k * 80 + tq * 16) = wk; *(LAS v4u*)(L + HG_VT + k * 80 + tq * 16) = wv;
    if (tq == 0) *(LAS float*)(L + HG_DEC + k * 4) = __expf(tot);
    return tot;
}
__device__ __forceinline__ void hgrn_update(const Ctx& F, f32x4 (&S)[8], int par) {
    LAS unsigned char* L = F.lds + par * HG_BUF; const int c16 = F.lane & 15, g = F.lane >> 4, w = F.wave;
    const bf16x8 vB = *(const LAS bf16x8*)(L + HG_VT + (16 * w + c16) * 80 + (8 * g) * 2);
#pragma unroll
    for (int a = 0; a < 8; ++a) {
        const f32x4 dc = *(const LAS f32x4*)(L + HG_DEC + (16 * a + 4 * g) * 4);
        const bf16x8 keA = *(const LAS bf16x8*)(L + HG_KET + (16 * a + c16) * 80 + (8 * g) * 2);
        S[a] = MFMA16(keA, vB, S[a] * dc);
    }
}
__device__ __forceinline__ void hgrn_pass1_unit(const Ctx& F, int u) {
    const int bh = u >> 4, seg = u & 15, b = bh >> 2, hh = bh & 3;
    f32x4 S[8];
#pragma unroll
    for (int a = 0; a < 8; ++a) S[a] = (f32x4){0.f, 0.f, 0.f, 0.f};
    float dsum = 0.f;
    HgIn cur; hgrn_load<false>(F, cur, b, hh, seg * 256);
    for (int c = 0; c < 8; ++c) {
        dsum += hgrn_stage<false>(F, cur, c & 1);
        if (c < 7) hgrn_load<false>(F, cur, b, hh, seg * 256 + (c + 1) * 32);
        __syncthreads();
        hgrn_update(F, S, c & 1);
    }
    if ((F.tid & 3) == 0) F.Dseg()[(size_t)u * 128 + (F.tid >> 2)] = __expf(dsum);
#pragma unroll
    for (int a = 0; a < 8; ++a) *(f32x4*)(F.Useg() + ((((size_t)u * 8 + F.wave) * 8 + a) * 64 + F.lane) * 4) = S[a];
    __syncthreads();
}
__device__ __forceinline__ void hgrn_pass2_unit(const Ctx& F, int u) {
    const int bh = u >> 4, seg = u & 15, b = bh >> 2, hh = bh & 3, lane = F.lane, w = F.wave, c16 = lane & 15, g = lane >> 4;
    f32x4 S[8];
#pragma unroll
    for (int a = 0; a < 8; ++a) S[a] = (f32x4){0.f, 0.f, 0.f, 0.f};
    HgIn cur; hgrn_load<true>(F, cur, b, hh, seg * 256);
    for (int sp = 0; sp < seg; ++sp) { const size_t pu = (size_t)bh * 16 + sp;
        f32x4 dc[8], U[8];
#pragma unroll
        for (int a = 0; a < 8; ++a) { dc[a] = *(const f32x4*)(F.Dseg() + pu * 128 + 16 * a + 4 * g); U[a] = *(const f32x4*)(F.Useg() + (((pu * 8 + w) * 8 + a) * 64 + lane) * 4); }
#pragma unroll
        for (int a = 0; a < 8; ++a) S[a] = S[a] * dc[a] + U[a]; }
    const int col = hh * 128 + 16 * w + c16; const float ng = F.hng[col];
    for (int c = 0; c < 8; ++c) {
        const int t0 = seg * 256 + c * 32, par = c & 1;
        LAS unsigned char* L = F.lds + par * HG_BUF;
        float hg[2][4];
#pragma unroll
        for (int it = 0; it < 2; ++it)
#pragma unroll
            for (int rg = 0; rg < 4; ++rg) hg[it][rg] = F.HG()[((size_t)b * SEQ + t0 + 16 * it + 4 * g + rg) * 512 + col];
        (void)hgrn_stage<true>(F, cur, par);
        if (c < 7) hgrn_load<true>(F, cur, b, hh, t0 + 32);
        __syncthreads();
        f32x4 am[2][2];
#pragma unroll
        for (int jt = 0; jt < 2; ++jt)
#pragma unroll
            for (int it = 0; it < 2; ++it) am[jt][it] = (f32x4){0.f, 0.f, 0.f, 0.f};
#pragma unroll
        for (int s4 = 0; s4 < 4; ++s4) {
            bf16x8 kdA[2], qdB[2];
#pragma unroll
            for (int t2 = 0; t2 < 2; ++t2) { kdA[t2] = *(const LAS bf16x8*)(L + HG_KD + (16 * t2 + c16) * 272 + (32 * s4 + 8 * g) * 2); qdB[t2] = *(const LAS bf16x8*)(L + HG_QD + (16 * t2 + c16) * 272 + (32 * s4 + 8 * g) * 2); }
#pragma unroll
            for (int jt = 0; jt < 2; ++jt)
#pragma unroll
                for (int it = 0; it < 2; ++it) am[jt][it] = MFMA16(kdA[jt], qdB[it], am[jt][it]);
        }
#pragma unroll
        for (int jt = 0; jt < 2; ++jt)
#pragma unroll
            for (int it = 0; it < 2; ++it)
#pragma unroll
                for (int rg = 0; rg < 4; ++rg) if (16 * jt + 4 * g + rg > 16 * it + c16) am[jt][it][rg] = 0.f;
        f32x4 o[2];
        { const LAS unsigned char* vb = L + HG_VT + (16 * w + c16) * 80 + (4 * g) * 2;
          const bf16x8 vB = join8(*(const LAS u32x2*)vb, *(const LAS u32x2*)(vb + 32));
#pragma unroll
          for (int it = 0; it < 2; ++it) o[it] = MFMA16(pack8(am[0][it], am[1][it]), vB, ((f32x4){0.f, 0.f, 0.f, 0.f})); }
#pragma unroll
        for (int kp = 0; kp < 4; ++kp) {
            const bf16x8 sB = pack8(S[2 * kp], S[2 * kp + 1]);
#pragma unroll
            for (int it = 0; it < 2; ++it) { const LAS unsigned char* qp = L + HG_QD + (16 * it + c16) * 272 + (32 * kp + 4 * g) * 2;
                o[it] = MFMA16(join8(*(const LAS u32x2*)qp, *(const LAS u32x2*)(qp + 32)), sB, o[it]); }
        }
        hgrn_update(F, S, par);
        LAS float* SSQ = (LAS float*)(F.lds + HG_SSQ) + par * 256;
#pragma unroll
        for (int it = 0; it < 2; ++it)
#pragma unroll
            for (int rg = 0; rg < 4; ++rg) { const float sq = row16_sum(o[it][rg] * o[it][rg]); if (c16 == 0) SSQ[w * 32 + 16 * it + 4 * g + rg] = sq; }
        __syncthreads();
#pragma unroll
        for (int it = 0; it < 2; ++it)
#pragma unroll
            for (int rg = 0; rg < 4; ++rg) { const int i = 16 * it + 4 * g + rg; float tot = 0.f;
#pragma unroll
                for (int w2 = 0; w2 < 8; ++w2) tot += SSQ[w2 * 32 + i];
                const float rstd = 1.0f / sqrtf(tot * (1.0f / 128.0f) + LN_EPS);
                const size_t row = (size_t)b * SEQ + t0 + i;
                F.Cat()[row * 1024 + 512 + col] = (bf16)f2bf(o[it][rg] * rstd * ng * hg[it][rg]); }
    }
    if (seg == 15) {
#pragma unroll
        for (int a = 0; a < 8; ++a)
#pragma unroll
            for (int rg = 0; rg < 4; ++rg) F.out[O_SP + ((size_t)bh * 128 + 16 * a + 4 * g + rg) * 128 + 16 * w + c16] = S[a][rg];
    }
    __syncthreads();
}
struct Args { const float* in[21]; float* out; unsigned char* ws; };
__global__ void __launch_bounds__(NWAVES * 64, 2) fwd_kernel(Args args) {
    extern __shared__ __attribute__((aligned(16))) unsigned char lds[];
    Ctx F;
    F.lds = (LAS unsigned char*)lds;
    const int wave_s = __builtin_amdgcn_readfirstlane((int)threadIdx.x >> 6);
    F.tid = threadIdx.x; F.lane = F.tid & 63; F.wave = wave_s; F.G = gridDim.x; F.bid = blockIdx.x;
    F.xp = args.in[0]; F.xs = args.in[1]; F.ck = args.in[2]; F.cv = args.in[3]; F.st0 = args.in[4]; F.w1g = args.in[5]; F.w1u = args.in[6]; F.w1d = args.in[7]; F.ln1g = args.in[8]; F.ln1b = args.in[9];
    F.win = args.in[10]; F.hlb = args.in[11]; F.hng = args.in[12]; F.wout = args.in[13]; F.ln2g = args.in[14]; F.ln2b = args.in[15]; F.w2g = args.in[16]; F.w2u = args.in[17]; F.w2d = args.in[18]; F.ln3g = args.in[19]; F.ln3b = args.in[20];
    F.out = args.out; F.ws = args.ws; unsigned char* ws = args.ws;


    for (int u = F.tid; u < (LDS_BYTES - LDSCTL_OFF) / 4; u += NWAVES * 64) ((LAS unsigned*)(F.lds + LDSCTL_OFF))[u] = 0u;
    __syncthreads();
    XcdBarrier bar = xcd_barrier_post((unsigned*)(ws + WS_CTL) + CW_BAR, (volatile LAS unsigned*)(F.lds + MISC_OFF) + 8);
#define REFRESH() do { int l_ = (int)__builtin_amdgcn_mbcnt_hi(~0u, __builtin_amdgcn_mbcnt_lo(~0u, 0u)); asm volatile("" : "+v"(l_)); F.lane = l_; F.wave = wave_s; F.tid = wave_s * 64 + l_; } while (0)
#define GRID_BAR() do { xcd_barrier(bar); REFRESH(); } while (0)
#define COPY_SETUP(S, off4, n4_, R) do { const int cb_ = F.bid & 127; const float* sp_ = (F.bid < 128 ? F.ck : F.cv) + (size_t)cb_ * 1048576 + 2048; float* dp_ = F.out + (F.bid < 128 ? O_KS : O_VS) + (size_t)cb_ * 1048576; \
        (S).src = (const f32x4*)sp_ + (off4); (S).dst = (f32x4*)dp_ + (off4); (S).n4 = (F.G == 256) ? (n4_) : 0; (S).slot = (F.bid >> 3) % (R); (S).tid = F.tid; (S).cnt = 0; } while (0)

#if PHMASK & 1
    for (int rep_ = 0; rep_ < ((REPMASK & 1) ? 2 : 1); ++rep_) {
    p0_prologue(F);
    }
#endif
    GRID_BAR();
#if PHMASK & 2
    for (int rep_ = 0; rep_ < ((REPMASK & 2) ? 2 : 1); ++rep_) {
    { pg8::Gemm g{F.Xb(), F.W1gu(), M, NGU, D, D}; pg8::CopyOrder S; S.init(M, NGU, F.G, F.bid); COPY_SETUP(S, 0, 100352, 5); pg8::EpiSwiGLU E{F.Hb(), FF};
      pg8::gemm_phase<pg8::EpiSwiGLU, pg8::CopyOrder, true, true>(F.lds + RING_OFF, g, S, E, F.tid); }
    }
#endif
    GRID_BAR();
#if PHMASK & 4
    for (int rep_ = 0; rep_ < ((REPMASK & 4) ? 2 : 1); ++rep_) {
    { pg8::Gemm g{F.Hb(), F.W1d(), MP, D, FF, FF}; pg8::StaticOrder S; S.init(MP, D, F.G, F.bid); pg8::EpiResid E{F.xp, F.xs, F.Ypre(), DN_ALPHA, 0.5f};
      pg8::gemm_phase<pg8::EpiResid, pg8::StaticOrder, true, true>(F.lds + RING_OFF, g, S, E, F.tid); }
    { pg8::Gemm g{F.Hb(), F.W1d(), M, D, 256, FF}; pg8::SplitOrder S{88, F.G, F.bid}; pg8::EpiPartial E{F.Slab()};
      pg8::gemm_phase<pg8::EpiPartial, pg8::SplitOrder, false, true>(F.lds + RING_OFF, g, S, E, F.tid); }
    }
#endif
    GRID_BAR();
#if PHMASK & 8
    for (int rep_ = 0; rep_ < ((REPMASK & 8) ? 2 : 1); ++rep_) {
    ln_rows(F, F.Ypre(), F.ln1g, F.ln1b, F.X1(), F.X1b(), F.xs, 11, 0.5f);
    }
#endif
    GRID_BAR();
#if PHMASK & 16
    for (int rep_ = 0; rep_ < ((REPMASK & 16) ? 2 : 1); ++rep_) {
    { pg8::Gemm g{F.X1b(), F.Win(), M, NIN, D, D}; pg8::CopyOrder S; S.init(M, NIN, F.G, F.bid); COPY_SETUP(S, 100352, 60928, 3);
      pg8::EpiWin E{F.Qb(), F.Kb(), F.Vb(), F.HQ(), F.LOGF(), F.KH(), F.HI(), F.HG(), F.COS(), F.SIN(), F.LB(), F.out + O_KP, F.out + O_VP, F.out + O_KS, F.out + O_VS};
      pg8::gemm_phase<pg8::EpiWin, pg8::CopyOrder, true, true>(F.lds + RING_OFF, g, S, E, F.tid); }
    }
#endif
    GRID_BAR();
#if PHMASK & 32
    for (int rep_ = 0; rep_ < ((REPMASK & 32) ? 2 : 1); ++rep_) {
    for (int u = F.bid; u < 256; u += F.G) hgrn_pass1_unit(F, u);
    }
#endif
#if PHMASK & 64
    for (int rep_ = 0; rep_ < ((REPMASK & 64) ? 2 : 1); ++rep_) {
    for (int u = F.bid; u < 3072; u += F.G) attn_prompt_unit(F, u);
    }
#endif
#if PHMASK & 128
    for (int rep_ = 0; rep_ < ((REPMASK & 128) ? 2 : 1); ++rep_) {
    for (int u = F.bid; u < 256; u += F.G) attn_sample_unit(F, u);
    }
#endif
#if PHMASK & 256
    for (int rep_ = 0; rep_ < ((REPMASK & 256) ? 2 : 1); ++rep_) {
    for (int u = F.bid; u < 512; u += F.G) hgrn_sample_unit(F, u);
    }
#endif
    GRID_BAR();
#if PHMASK & 512
    for (int rep_ = 0; rep_ < ((REPMASK & 512) ? 2 : 1); ++rep_) {
    for (int u = F.bid; u < 256; u += F.G) hgrn_pass2_unit(F, u);
    }
#endif
#if PHMASK & 1024
    for (int rep_ = 0; rep_ < ((REPMASK & 1024) ? 2 : 1); ++rep_) {
    attn_combine_rows(F);
    }
#endif
    GRID_BAR();
#if PHMASK & 2048
    for (int rep_ = 0; rep_ < ((REPMASK & 2048) ? 2 : 1); ++rep_) {
    { pg8::Gemm g{F.Cat(), F.Wout(), MP, D, D, D}; pg8::StaticOrder S; S.init(MP, D, F.G, F.bid); pg8::EpiResid E{F.X1(), F.X1() + (size_t)MP * D, F.Ypre(), DN_ALPHA, 1.0f};
      pg8::gemm_phase<pg8::EpiResid, pg8::StaticOrder, true, true>(F.lds + RING_OFF, g, S, E, F.tid); }
    { pg8::Gemm g{F.Cat(), F.Wout(), M, D, 256, D}; pg8::SplitOrder S{32, F.G, F.bid}; pg8::EpiPartial E{F.Slab()};
      pg8::gemm_phase<pg8::EpiPartial, pg8::SplitOrder, false, true>(F.lds + RING_OFF, g, S, E, F.tid); }
    }
#endif
    GRID_BAR();
    ln_rows(F, F.Ypre(), F.ln2g, F.ln2b, F.X2(), F.X2b(), F.X1() + (size_t)MP * D, 4, 1.0f);
    GRID_BAR();
    { pg8::Gemm g{F.X2b(), F.W2gu(), M, NGU, D, D}; pg8::CopyOrder S; S.init(M, NGU, F.G, F.bid); COPY_SETUP(S, 161280, 100352, 5); pg8::EpiSwiGLU E{F.Hb(), FF};
      pg8::gemm_phase<pg8::EpiSwiGLU, pg8::CopyOrder, true, true>(F.lds + RING_OFF, g, S, E, F.tid); }
    GRID_BAR();
    { pg8::Gemm g{F.Hb(), F.W2d(), MP, D, FF, FF}; pg8::StaticOrder S; S.init(MP, D, F.G, F.bid); pg8::EpiResid E{F.X2(), F.X2() + (size_t)MP * D, F.Ypre(), DN_ALPHA, 0.5f};
      pg8::gemm_phase<pg8::EpiResid, pg8::StaticOrder, true, true>(F.lds + RING_OFF, g, S, E, F.tid); }
    { pg8::Gemm g{F.Hb(), F.W2d(), M, D, 256, FF}; pg8::SplitOrder S{88, F.G, F.bid}; pg8::EpiPartial E{F.Slab()};
      pg8::gemm_phase<pg8::EpiPartial, pg8::SplitOrder, false, true>(F.lds + RING_OFF, g, S, E, F.tid); }
    GRID_BAR();
    ln_rows(F, F.Ypre(), F.ln3g, F.ln3b, F.out + O_YP, (bf16*)nullptr, F.X2() + (size_t)MP * D, 11, 0.5f);
}
#if DBG
constexpr int DBG_NST = 14, DBG_NS = 6;
__device__ __forceinline__ unsigned dhash(unsigned x) { x ^= x >> 16; x *= 0x7feb352dU; x ^= x >> 15; x *= 0x846ca68bU; x ^= x >> 16; return x; }
__device__ __forceinline__ float dbf(bf16 h) { return bf2f((unsigned)h); }
__device__ __forceinline__ float rbf(float x) { return bf2f(f2bf(x)); }
__device__ __forceinline__ float dsig(float x) { return 1.0f / (1.0f + __expf(-x)); }
__device__ __forceinline__ void dmax(unsigned* slot, float e) { unsigned b = (e != e) ? 0x7fc00000u : __builtin_bit_cast(unsigned, fabsf(e)); atomicMax(slot, b); }
__device__ __forceinline__ float block_sum1024(float v, float* sh) {
    v = wave_sum(v); __syncthreads(); if ((threadIdx.x & 63) == 0) sh[threadIdx.x >> 6] = v; __syncthreads(); float t = 0.f; for (int i = 0; i < 16; ++i) t += sh[i]; __syncthreads(); return t;
}
__device__ void dbg_ffn_row(const float* res, const bf16* xb, const bf16* Wgu, const bf16* Wd, const float* lg, const float* lb, const float* got, unsigned* slot, float* hs, float* ys, float* sh) {
    const int tid = threadIdx.x;
    for (int hc = tid; hc < FF; hc += 1024) {
        const bf16* wg = Wgu + (size_t)(256 * (hc >> 7) + (hc & 127)) * D; const bf16* wu = wg + (size_t)128 * D; float g = 0.f, u = 0.f;
        for (int k = 0; k < D; ++k) { const float x = dbf(xb[k]); g += x * dbf(wg[k]); u += x * dbf(wu[k]); }
        hs[hc] = rbf(g * dsig(g) * u);
    }
    __syncthreads();
    float acc = 0.f; { const bf16* wd = Wd + (size_t)tid * FF; for (int j = 0; j < FF; ++j) acc += hs[j] * dbf(wd[j]); }
    const float y = DN_ALPHA * res[tid] + 0.5f * acc;
    const float mean = block_sum1024(y, sh) * (1.f / D); const float var = block_sum1024((y - mean) * (y - mean), sh) * (1.f / D);
    const float want = (y - mean) / sqrtf(var + LN_EPS) * lg[tid] + lb[tid];
    dmax(slot, (got[tid] - want)); (void)ys;
}
__global__ void __launch_bounds__(1024, 1) dbg_check(Args args) {
    __shared__ float hs[FF]; __shared__ float ys[1024]; __shared__ float sh[64]; __shared__ float ov[128];
    Ctx F; unsigned char* ws = args.ws;
    F.xp = args.in[0]; F.xs = args.in[1]; F.ck = args.in[2]; F.cv = args.in[3]; F.st0 = args.in[4]; F.w1g = args.in[5]; F.w1u = args.in[6]; F.w1d = args.in[7]; F.ln1g = args.in[8]; F.ln1b = args.in[9];
    F.win = args.in[10]; F.hlb = args.in[11]; F.hng = args.in[12]; F.wout = args.in[13]; F.ln2g = args.in[14]; F.ln2b = args.in[15]; F.w2g = args.in[16]; F.w2u = args.in[17]; F.w2d = args.in[18]; F.ln3g = args.in[19]; F.ln3b = args.in[20];
    F.out = args.out; F.ws = ws;


    unsigned* DB = (unsigned*)(ws + WS_DBG);
    const int stage = blockIdx.x / DBG_NS, smp = blockIdx.x % DBG_NS, tid = threadIdx.x;
    unsigned* slot = DB + stage;
    const unsigned hb = dhash(blockIdx.x * 7919u + 13u), ht = dhash(hb + tid * 2654435761u);
    if (stage == 0) {
        { const int c = ht % FF, k = dhash(ht + 1) % D; dmax(slot, dbf(F.W1gu()[(size_t)(256 * (c >> 7) + (c & 127)) * D + k]) - rbf(F.w1g[(size_t)k * FF + c])); dmax(slot, dbf(F.W1gu()[(size_t)(256 * (c >> 7) + 128 + (c & 127)) * D + k]) - rbf(F.w1u[(size_t)k * FF + c]));
          dmax(slot, dbf(F.W2gu()[(size_t)(256 * (c >> 7) + (c & 127)) * D + k]) - rbf(F.w2g[(size_t)k * FF + c])); dmax(slot, dbf(F.W2gu()[(size_t)(256 * (c >> 7) + 128 + (c & 127)) * D + k]) - rbf(F.w2u[(size_t)k * FF + c])); }
        { const int c = ht % D, k = dhash(ht + 2) % FF; dmax(slot, dbf(F.W1d()[(size_t)c * FF + k]) - rbf(F.w1d[(size_t)k * D + c])); dmax(slot, dbf(F.W2d()[(size_t)c * FF + k]) - rbf(F.w2d[(size_t)k * D + c])); }
        { const int c = ht % NIN, k = dhash(ht + 3) % D; dmax(slot, dbf(F.Win()[(size_t)RmWin()(c) * D + k]) - rbf(F.win[(size_t)k * NIN + c])); }
        { const int c = ht % D, k = dhash(ht + 4) % D; dmax(slot, dbf(F.Wout()[(size_t)c * D + k]) - rbf(F.wout[(size_t)k * D + c])); }
    } else if (stage == 1) {
        const int m = ht % M, c = dhash(ht + 1) % D; const float x = m < MP ? F.xp[(size_t)m * D + c] : F.xs[(size_t)(m - MP) * D + c]; dmax(slot, dbf(F.Xb()[(size_t)m * D + c]) - rbf(x));
    } else if (stage == 2) {
        const int pi = (smp == 0 && tid < 8) ? 4092 + tid : (int)(ht % 4100), i = dhash(ht + 1) & 31; const int pos = pi < 4096 ? pi : 8192 + (pi - 4096);
        const float ang = (float)pos * INV_FREQ[i]; double r = (double)ang; r -= 6.283185307179586 * __builtin_rint(r * 0.15915494309189535);
        double sn = 0., cs = 0., term = 1.; for (int n = 0; n < 30; ++n) { if (n & 1) sn += ((n >> 1) & 1) ? -term : term; else cs += ((n >> 1) & 1) ? -term : term; term *= r / (double)(n + 1); }
        dmax(slot, F.COS()[pi * 32 + i] - (float)cs); dmax(slot, F.SIN()[pi * 32 + i] - (float)sn);
    } else if (stage == 3) {
        if (tid < 512) { const float a0 = F.hlb[tid], a1 = F.hlb[512 + tid]; dmax(slot, F.LB()[tid] - 1.0f / (1.0f + expf(a1 - a0))); }
    } else if (stage == 4) {
        const int b = ht & 127, rr = dhash(ht + 1) % 2044, c = dhash(ht + 2) & 511;
        dmax(slot, F.out[O_KS + ((size_t)b * 2048 + rr) * 512 + c] - F.ck[((size_t)b * 2048 + rr + 4) * 512 + c]); dmax(slot, F.out[O_VS + ((size_t)b * 2048 + rr) * 512 + c] - F.cv[((size_t)b * 2048 + rr + 4) * 512 + c]);
    } else if (stage == 5 || stage == 13) {
        const int m = (smp < 4) ? (int)(hb % MP) : MP + (int)(hb % MS);
        if (stage == 5) dbg_ffn_row(m < MP ? F.xp + (size_t)m * D : F.xs + (size_t)(m - MP) * D, F.Xb() + (size_t)m * D, F.W1gu(), F.W1d(), F.ln1g, F.ln1b, F.X1() + (size_t)m * D, slot, hs, ys, sh);
        else dbg_ffn_row(F.X2() + (size_t)m * D, F.X2b() + (size_t)m * D, F.W2gu(), F.W2d(), F.ln3g, F.ln3b, F.out + O_YP + (size_t)m * D, slot, hs, ys, sh);
    } else if (stage == 6) {
        const int m = (tid & 3) ? (int)(ht % MP) : ((tid & 4) ? MP + (int)(ht % MS) : (int)((ht % 4) * SEQ + 2048 + (dhash(ht + 9) % 2048))); const int col = dhash(ht + 1) % NIN;
        const int typ = col >> 9, c5 = col & 511; const bf16* xr = F.X1b() + (size_t)m * D;
        const int pi = m < MP ? (m & 4095) : 4096 + ((m - MP) & 3);
        float* fk = nullptr; if (m >= MP) fk = F.out + ((size_t)(((m - MP) >> 2) * 2048 + 2044 + ((m - MP) & 3))) * 512; else if ((m & 4095) >= 2048) fk = F.out + ((size_t)((m >> 12) * 2048 + (m & 4095) - 2048)) * 512;
        if (typ <= 1) {
            const int e = c5 & 63, e1 = e & 31, cb = col - e; float x1 = 0.f, x2 = 0.f; const bf16* w1 = F.Win() + (size_t)RmWin()(cb + e1) * D; const bf16* w2 = F.Win() + (size_t)RmWin()(cb + e1 + 32) * D;
            for (int k = 0; k < D; ++k) { const float x = dbf(xr[k]); x1 += x * dbf(w1[k]); x2 += x * dbf(w2[k]); }
            const float cs = F.COS()[pi * 32 + e1], sn = F.SIN()[pi * 32 + e1]; const float want = e < 32 ? x1 * cs - x2 * sn : x2 * cs + x1 * sn;
            const float got = dbf((typ == 0 ? F.Qb() : F.Kb())[(size_t)m * 512 + c5]); dmax(slot, (got - want) / (fabsf(want) + 0.2f));
            if (typ == 1 && fk) dmax(slot, (fk[(m >= MP ? O_KS : O_KP) + c5] - want) / (fabsf(want) + 0.2f));
        } else {
            float z = 0.f; const bf16* w1 = F.Win() + (size_t)col * D; for (int k = 0; k < D; ++k) z += dbf(xr[k]) * dbf(w1[k]);
            const size_t off = (size_t)m * 512 + c5;
            if (typ == 2) { dmax(slot, (dbf(F.Vb()[off]) - z) / (fabsf(z) + 0.1f)); if (fk) dmax(slot, (fk[(m >= MP ? O_VS : O_VP) + c5] - z) / (fabsf(z) + 0.1f)); }
            else if (typ == 3) dmax(slot, (F.HQ()[off] - z * dsig(z)) / (fabsf(z) + 0.1f));
            else if (typ == 4) { const float lb = 1.0f / (1.0f + expf(F.hlb[512 + c5] - F.hlb[c5])); const float f = lb + (1.f - lb) * dsig(z); dmax(slot, F.LOGF()[off] - logf(f)); dmax(slot, F.KH()[off] - (1.f - f)); }
            else if (typ == 5) dmax(slot, (F.HI()[off] - z) / (fabsf(z) + 0.1f));
            else dmax(slot, (F.HG()[off] - z * dsig(z)) / (fabsf(z) + 0.1f));
        }
    } else if (stage == 7 || stage == 8) {
        const int wv = tid >> 6, e = tid & 63; const unsigned hw = dhash(hb + wv * 977u);
        const int h = hw & 7; int m; if (stage == 7) { const int tsel = (wv & 3) == 0 ? (int)(dhash(hw + 1) % 140) : (int)(dhash(hw + 1) % SEQ); m = (int)(dhash(hw + 2) % 4) * SEQ + tsel; } else m = MP + (int)(dhash(hw + 1) % MS);
        const float qe = dbf(F.Qb()[(size_t)m * 512 + h * 64 + e]);
        float lse[3], ob[3];
        for (int di = 0; di < 3; ++di) {
            const int d = 1 << (2 * di); float mx = -INFINITY, l = 0.f, acc = 0.f;
            for (int j = 0; j <= 128; ++j) {
                float kv, vv;
                if (stage == 7) { const int t = (m & 4095) - d * j; if (t < 0) break; const size_t r = (size_t)(m - (m & 4095) + t) * 512 + h * 64 + e; kv = dbf(F.Kb()[r]); vv = dbf(F.Vb()[r]); }
                else { const int bd = (m - MP) >> 2, s = (m - MP) & 3, idx = 2048 + s - d * j; const size_t r = idx < 2048 ? ((size_t)(bd * 2048 + idx) * 512 + h * 64 + e) : ((size_t)(bd * 2048 + 2044 + idx - 2048) * 512 + h * 64 + e);
                       kv = idx < 2048 ? F.ck[r] : F.out[O_KS + r]; vv = idx < 2048 ? F.cv[r] : F.out[O_VS + r]; }
                const float sc = wave_sum(qe * kv) * 0.125f; const float nm = fmaxf(mx, sc); const float corr = __expf(mx - nm), p = __expf(sc - nm); l = l * corr + p; acc = acc * corr + p * vv; mx = nm;
            }
            lse[di] = mx + logf(l); ob[di] = acc / l;
        }
        const float ml = fmaxf(lse[0], fmaxf(lse[1], lse[2])); const float w0 = __expf(lse[0] - ml), w1 = __expf(lse[1] - ml), w2 = __expf(lse[2] - ml);
        const float want = (w0 * ob[0] + w1 * ob[1] + w2 * ob[2]) / (w0 + w1 + w2);
        dmax(slot, (dbf(F.Cat()[(size_t)m * 1024 + h * 64 + e]) - want) / (fabsf(want) + 0.05f));
    } else if (stage == 9 || stage == 10) {
        const int k = tid & 127, vg = tid >> 7; float S[16];
        int b = 0, hh = hb & 3, tt = 0, nstep; size_t row0;
        if (stage == 9) { b = (hb >> 2) & 3; tt = smp == 0 ? 3 : smp == 1 ? 40 : smp == 2 ? 300 : smp == 3 ? 1500 : smp == 4 ? 4095 : 2047; nstep = tt + 1; row0 = (size_t)b * SEQ;
#pragma unroll
            for (int i = 0; i < 16; ++i) S[i] = 0.f; }
        else { b = (hb >> 2) & 127; nstep = 4; tt = 3; row0 = (size_t)MP + b * 4;
#pragma unroll
            for (int i = 0; i < 16; ++i) S[i] = F.st0[((size_t)(b * 4 + hh) * 128 + k) * 128 + 16 * vg + i]; }
        for (int t = 0; t < nstep; ++t) { const size_t base = (row0 + t) * 512 + hh * 128; const float kh = F.KH()[base + k], f = __expf(F.LOGF()[base + k]);
#pragma unroll
            for (int i = 0; i < 16; ++i) S[i] = f * S[i] + kh * F.HI()[base + 16 * vg + i];
            if (t == tt || stage == 10) {
                const float q = F.HQ()[base + k];
#pragma unroll
                for (int i = 0; i < 16; ++i) { const float ps = wave_sum(q * S[i]); if ((tid & 63) == 0) sh[(tid >> 6) * 1 + 0] = ps; __syncthreads(); if (k == 0) ov[16 * vg + i] = sh[2 * vg] + sh[2 * vg + 1]; __syncthreads(); }
                float ssq = 0.f; for (int v = 0; v < 128; ++v) ssq += ov[v] * ov[v];
                const float rstd = 1.0f / sqrtf(ssq / 128.f + LN_EPS);
                if (tid < 128) { const int col = hh * 128 + tid; const float want = ov[tid] * rstd * F.hng[col] * F.HG()[(row0 + t) * 512 + col]; dmax(slot, (dbf(F.Cat()[(row0 + t) * 1024 + 512 + col]) - want) / (fabsf(want) + 0.05f)); }
                __syncthreads();
            }
        }
        if (stage == 10) { for (int i = 0; i < 16; ++i) dmax(slot, (F.out[O_SS + ((size_t)(b * 4 + hh) * 128 + k) * 128 + 16 * vg + i] - S[i]) / (fabsf(S[i]) + 0.1f)); }
        else if (tt == 4095) { for (int i = 0; i < 16; ++i) dmax(slot, (F.out[O_SP + ((size_t)(b * 4 + hh) * 128 + k) * 128 + 16 * vg + i] - S[i]) / (fabsf(S[i]) + 0.1f)); }
    } else if (stage == 11) {
        const int m = (smp < 4) ? (int)(hb % MP) : MP + (int)(hb % MS); float acc = 0.f; const bf16* cr = F.Cat() + (size_t)m * D; const bf16* wr = F.Wout() + (size_t)tid * D;
        for (int k = 0; k < D; ++k) acc += dbf(cr[k]) * dbf(wr[k]);
        const float y = DN_ALPHA * F.X1()[(size_t)m * D + tid] + acc;
        const float mean = block_sum1024(y, sh) * (1.f / D); const float var = block_sum1024((y - mean) * (y - mean), sh) * (1.f / D);
        const float want = (y - mean) / sqrtf(var + LN_EPS) * F.ln2g[tid] + F.ln2b[tid];
        dmax(slot, F.X2()[(size_t)m * D + tid] - want); dmax(slot, dbf(F.X2b()[(size_t)m * D + tid]) - rbf(F.X2()[(size_t)m * D + tid]));
    } else if (stage == 12) {
        const int m = ht % M, hc = dhash(ht + 1) % FF; const bf16* xr = F.X2b() + (size_t)m * D; const bf16* wg = F.W2gu() + (size_t)(256 * (hc >> 7) + (hc & 127)) * D; const bf16* wu = wg + (size_t)128 * D; float g = 0.f, u = 0.f;
        for (int k = 0; k < D; ++k) { const float x = dbf(xr[k]); g += x * dbf(wg[k]); u += x * dbf(wu[k]); }
        const float want = g * dsig(g) * u; dmax(slot, (dbf(F.Hb()[(size_t)m * FF + hc]) - want) / (fabsf(want) + 0.05f));
    }
}
__constant__ float DBG_TOL[DBG_NST] = {1e-6f, 1e-6f, 1e-4f, 1e-5f, 0.f, 5e-3f, 3e-2f, 4e-2f, 4e-2f, 6e-2f, 6e-2f, 5e-3f, 3e-2f, 5e-3f};
__global__ void dbg_emit(Args args) {
    if (threadIdx.x != 0) return;
    const unsigned* DB = (const unsigned*)(args.ws + WS_DBG);
    for (int s = 0; s < DBG_NST; ++s) {
        const float e = __builtin_bit_cast(float, DB[s]);
        if (!(e <= DBG_TOL[s])) {
            float mant = 9.5f; if (e == e) { float q = -10.0f * log10f(fmaxf(e, 1e-8f)); q = fminf(fmaxf(q, 0.f), 80.f); mant = 1.0f + floorf(q + 0.5f) / 10.0f; }
            float c = mant * 1e4f; for (int i = 0; i < s; ++i) c *= 10.0f;
            args.out[0] = c; return;
        }
    }
}
#define DBG_LAUNCH() do { (void)hipMemsetAsync((char*)d_ws + WS_DBG, 0, 4096, stream); hipLaunchKernelGGL(dbg_check, dim3(DBG_NST * DBG_NS), dim3(1024), 0, stream, a); hipLaunchKernelGGL(dbg_emit, dim3(1), dim3(64), 0, stream, a); } while (0)
#else
#define DBG_LAUNCH() do { } while (0)
#endif
extern "C" void kernel_launch(void* const* d_in, const int* in_sizes, int n_in, void* d_out, int out_size, void* d_ws, size_t ws_size, hipStream_t stream) {
    static int grid = 0;
    if (grid == 0) {
        if (n_in != 21 || (size_t)out_size != O_END || ws_size < WS_END) { fprintf(stderr, "kernel_launch: unexpected sizes n_in %d out %d ws %zu\n", n_in, out_size, ws_size); grid = -1; return; }
        int dev = 0, cus = 0, per_cu = 0;
        if (hipGetDevice(&dev) != hipSuccess || hipDeviceGetAttribute(&cus, hipDeviceAttributeMultiprocessorCount, dev) != hipSuccess) { grid = -1; return; }
        if (hipFuncSetAttribute((const void*)fwd_kernel, hipFuncAttributeMaxDynamicSharedMemorySize, LDS_BYTES) != hipSuccess) { fprintf(stderr, "kernel_launch: hipFuncSetAttribute failed\n"); grid = -1; return; }
        if (hipOccupancyMaxActiveBlocksPerMultiprocessor(&per_cu, (const void*)fwd_kernel, NWAVES * 64, LDS_BYTES) != hipSuccess || per_cu < 1) { fprintf(stderr, "kernel_launch: occupancy query says %d\n", per_cu); }
        (void)hipGetLastError();
        grid = cus;
    }
    if (grid < 0) return;
    if (hipMemsetAsync((char*)d_ws + WS_CTL, 0, CTL_ZERO_BYTES, stream) != hipSuccess) return;
    Args a{};
    for (int i = 0; i < 21; ++i) a.in[i] = (const float*)d_in[i];
    a.out = (float*)d_out; a.ws = (unsigned char*)d_ws;
    hipLaunchKernelGGL(fwd_kernel, dim3(grid), dim3(NWAVES * 64), LDS_BYTES, stream, a);
    DBG_LAUNCH();
}
```
